# Optimizing an MI355X kernel written in HIP

```python
import jax, jax.numpy as jnp
from jax import lax
import numpy as np

D_MODEL = 1024
BATCH = 8
SEQ = 4096
DEPTH = 1

CONV_WIDTH = D_MODEL
CONV_KERNEL = 31
HEAD_DIM = 64
N_Q_HEADS = 16
N_KV_HEADS = 4
GROUP = N_Q_HEADS // N_KV_HEADS
ATTN_WIDTH = N_Q_HEADS * HEAD_DIM
KV_WIDTH = N_KV_HEADS * HEAD_DIM
WINDOW = 128
BLOCK = 128
ROPE_THETA = 10000.0
RMS_EPS = 1e-5
LN_EPS = 1e-5
N_BRANCHES = 2

SECTION_WIDTHS = (
    2 * CONV_WIDTH,
    CONV_WIDTH,
    ATTN_WIDTH,
    KV_WIDTH,
    KV_WIDTH,
    ATTN_WIDTH,
    N_BRANCHES * D_MODEL,
)
SPLIT_POINTS = tuple(int(v) for v in np.cumsum(SECTION_WIDTHS)[:-1])
IN_WIDTH = sum(SECTION_WIDTHS)

kernel_name = "hybrid_conformer_conv_swa_sink_gated_block"


def rmsnorm(x, g):
    xf = x.astype(jnp.float32)
    y = xf * lax.rsqrt(jnp.mean(xf * xf, axis=-1, keepdims=True) + RMS_EPS)
    return (y * g.astype(jnp.float32)).astype(x.dtype)


def layernorm(x, g, b):
    xf = x.astype(jnp.float32)
    mu = jnp.mean(xf, axis=-1, keepdims=True)
    var = jnp.mean(jnp.square(xf - mu), axis=-1, keepdims=True)
    y = (xf - mu) * lax.rsqrt(var + LN_EPS)
    return (y * g.astype(jnp.float32) + b.astype(jnp.float32)).astype(x.dtype)


def rope(t, pos):
    inv_freq = ROPE_THETA ** (-jnp.arange(0, HEAD_DIM, 2, dtype=jnp.float32) / HEAD_DIM)
    ang = pos.astype(jnp.float32)[:, None] * inv_freq[None, :]
    cos = jnp.cos(ang)[None, :, None, :]
    sin = jnp.sin(ang)[None, :, None, :]
    tf = t.astype(jnp.float32)
    t1, t2 = jnp.split(tf, 2, axis=-1)
    out = jnp.concatenate([t1 * cos - t2 * sin, t2 * cos + t1 * sin], axis=-1)
    return out.astype(t.dtype)


def conformer_conv(glu_in, w_dw, b_dw, ln_g, ln_b):
    a, b = jnp.split(glu_in, 2, axis=-1)
    h = a * jax.nn.sigmoid(b)
    h = lax.conv_general_dilated(
        h, w_dw[:, None, :].astype(h.dtype), window_strides=(1,),
        padding=[(CONV_KERNEL - 1, 0)],
        dimension_numbers=("NWC", "WIO", "NWC"),
        feature_group_count=CONV_WIDTH) + b_dw
    h = layernorm(h, ln_g, ln_b)
    return jax.nn.silu(h)


def sliding_window_attention(q, k, v, sinks):
    B, S = q.shape[0], q.shape[1]
    nb = S // BLOCK
    qb = q.reshape(B, nb, BLOCK, N_KV_HEADS, GROUP, HEAD_DIM)

    def band(t):
        tb = t.reshape(B, nb, BLOCK, N_KV_HEADS, HEAD_DIM)
        prev = jnp.pad(tb, ((0, 0), (1, 0), (0, 0), (0, 0), (0, 0)))[:, :-1]
        return jnp.concatenate([prev, tb], axis=2)

    kb, vb = band(k), band(v)
    scores = jnp.einsum("bnqhgd,bnkhd->bnhgqk", qb, kb).astype(jnp.float32) * (HEAD_DIM ** -0.5)
    qi = jnp.arange(BLOCK)[:, None]
    kj = jnp.arange(2 * BLOCK)[None, :]
    rel = qi + BLOCK - kj
    in_window = (rel >= 0) & (rel < WINDOW)
    key_pos = jnp.arange(nb)[:, None, None] * BLOCK - BLOCK + kj[None]
    mask = in_window[None] & (key_pos >= 0)
    scores = jnp.where(mask[None, :, None, None], scores, jnp.float32(-1e30))
    sink = sinks.astype(jnp.float32).reshape(N_KV_HEADS, GROUP)[None, None, :, :, None, None]
    m = jnp.maximum(jnp.max(scores, axis=-1, keepdims=True), sink)
    p = jnp.exp(scores - m)
    denom = jnp.sum(p, axis=-1, keepdims=True) + jnp.exp(sink - m)
    probs = (p / denom).astype(v.dtype)
    out = jnp.einsum("bnhgqk,bnkhd->bnqhgd", probs, vb)
    return out.reshape(B, S, ATTN_WIDTH)


def setup_inputs(seed: int = 0) -> dict:
    key = jax.random.key(seed)
    ks = jax.random.split(key, 13)
    f32 = jnp.float32
    x = jax.random.normal(ks[0], (BATCH, SEQ, D_MODEL), f32)
    norm_g = 1.0 + 0.02 * jax.random.normal(ks[1], (DEPTH, D_MODEL), f32)
    w_in = jax.random.normal(ks[2], (DEPTH, D_MODEL, IN_WIDTH), f32) * D_MODEL ** -0.5
    conv_dw_w = jax.random.normal(ks[3], (DEPTH, CONV_KERNEL, CONV_WIDTH), f32) * CONV_KERNEL ** -0.5
    conv_dw_b = 0.02 * jax.random.normal(ks[4], (DEPTH, CONV_WIDTH), f32)
    conv_ln_g = 1.0 + 0.02 * jax.random.normal(ks[5], (DEPTH, CONV_WIDTH), f32)
    conv_ln_b = 0.02 * jax.random.normal(ks[6], (DEPTH, CONV_WIDTH), f32)
    w_conv_out = jax.random.normal(ks[7], (DEPTH, CONV_WIDTH, D_MODEL), f32) * CONV_WIDTH ** -0.5
    attn_sinks = 0.5 * jax.random.normal(ks[8], (DEPTH, N_Q_HEADS), f32)
    w_attn_out = jax.random.normal(ks[9], (DEPTH, ATTN_WIDTH, D_MODEL), f32) * ATTN_WIDTH ** -0.5
    w_out = jax.random.normal(ks[10], (DEPTH, D_MODEL, D_MODEL), f32) * D_MODEL ** -0.5
    final_norm_g = 1.0 + 0.02 * jax.random.normal(ks[11], (D_MODEL,), f32)
    return {"x": x, "norm_g": norm_g, "w_in": w_in, "conv_dw_w": conv_dw_w,
            "conv_dw_b": conv_dw_b, "conv_ln_g": conv_ln_g, "conv_ln_b": conv_ln_b,
            "w_conv_out": w_conv_out, "attn_sinks": attn_sinks, "w_attn_out": w_attn_out,
            "w_out": w_out, "final_norm_g": final_norm_g}


def reference(x, norm_g, w_in, conv_dw_w, conv_dw_b, conv_ln_g, conv_ln_b,
              w_conv_out, attn_sinks, w_attn_out, w_out, final_norm_g):
    B, S = x.shape[0], x.shape[1]
    pos = jnp.arange(S, dtype=jnp.int32)
    for l in range(DEPTH):
        h = rmsnorm(x, norm_g[l])
        proj = jnp.einsum("bsd,de->bse", h, w_in[l])
        glu_in, conv_gate, q, k, v, attn_gate, merge_logits = jnp.split(proj, SPLIT_POINTS, axis=-1)

        c = conformer_conv(glu_in, conv_dw_w[l], conv_dw_b[l], conv_ln_g[l], conv_ln_b[l])
        y_conv = jnp.einsum("bsc,cd->bsd", c * jax.nn.silu(conv_gate), w_conv_out[l])

        q = rope(q.reshape(B, S, N_Q_HEADS, HEAD_DIM), pos)
        k = rope(k.reshape(B, S, N_KV_HEADS, HEAD_DIM), pos)
        v = v.reshape(B, S, N_KV_HEADS, HEAD_DIM)
        a = sliding_window_attention(q, k, v, attn_sinks[l])
        y_attn = jnp.einsum("bsa,ad->bsd", a * jax.nn.silu(attn_gate), w_attn_out[l])

        gates = jax.nn.sigmoid(merge_logits)
        g_conv, g_attn = jnp.split(gates, 2, axis=-1)
        merged = g_conv * y_conv + g_attn * y_attn
        x = x + jnp.einsum("bsd,de->bse", merged, w_out[l])
    return rmsnorm(x, final_norm_g)
```

```cpp
#include <hip/hip_runtime.h>
#include <hip/hip_cooperative_groups.h>
#include <cstdio>
#include <cstdint>
namespace cg = cooperative_groups;
namespace pg8 {
#define PG8_LAS __attribute__((address_space(3)))
typedef unsigned short bf16_t;
typedef short bf16x8 __attribute__((ext_vector_type(8)));
typedef float f32x4 __attribute__((ext_vector_type(4)));
typedef unsigned u32x4 __attribute__((ext_vector_type(4)));
constexpr int BM = 256, BK = 64, HALF = 128, HTB = HALF * BK * 2  , STAGE_BYTES = 8 * HTB, NXCD = 8, WGM = 8;

__host__ __device__ __forceinline__ int lds_byte(int r, int c) { const int st = (r >> 4) * 2 + (c >> 5), rr = r & 15, cc = c & 31, ob = rr * 64 + cc * 2; return st * 1024 + (ob ^ (((ob >> 9) & 1) << 5)); }
__host__ __device__ __forceinline__ void stage_rc(int b, int& R, int& C) { const int st = b / 1024, sb = b % 1024, swz = sb ^ (((sb >> 9) & 1) << 5); R = (st >> 1) * 16 + swz / 64; C = (st & 1) * 32 + (swz % 64) / 2; }
__host__ __device__ __forceinline__ int perm32(int rho) { const int n = rho >> 4, i = rho & 15; return 8 * (i >> 2) + 4 * n + (i & 3); }

struct Unit { int pm, pn; };
struct Gemm { const bf16_t* A; const bf16_t* Bt; int M, N, K, lda; };

struct StaticOrder {
    int nM, nN, nwg, G, c;
    __host__ __device__ void init(int M, int N, int G_, int c_) { nM = M / BM; nN = N / BM; nwg = nM * nN; G = G_; c = c_; }
    __host__ __device__ bool next(int i, Unit& u) const {
        const long L = (long)i * G + c; if (L >= nwg) return false;
        int wgid = (int)L; { const int q = nwg / NXCD, r = nwg % NXCD, xcd = wgid % NXCD, off = wgid / NXCD; wgid = (xcd < r ? xcd * (q + 1) : r * (q + 1) + (xcd - r) * q) + off; }
        const int nig = WGM * nN, gid = wgid / nig, fm = gid * WGM, gsz = (nM - fm) < WGM ? (nM - fm) : WGM;
        u.pm = fm + ((wgid % nig) % gsz); u.pn = (wgid % nig) / gsz; return true;
    }
    __device__ __forceinline__ void a_ready(const Unit&) const {}
    __device__ __forceinline__ void done(const Unit&) const {}
};


typedef float f32x2_t __attribute__((ext_vector_type(2))); typedef __bf16 bf16x2_t __attribute__((ext_vector_type(2)));
__device__ __forceinline__ unsigned cvt_pk_bf16(float lo, float hi) { f32x2_t v = {lo, hi}; bf16x2_t b = __builtin_convertvector(v, bf16x2_t); return __builtin_bit_cast(unsigned, b); }
__device__ __forceinline__ float fsig(float x) { return __builtin_amdgcn_rcpf(1.f + __builtin_amdgcn_exp2f(-1.4426950408889634f * x)); }
__device__ __forceinline__ f32x4 sig4(f32x4 v) { return (f32x4){fsig(v[0]), fsig(v[1]), fsig(v[2]), fsig(v[3])}; }
__device__ __forceinline__ void store8(bf16_t* p, f32x4 v0, f32x4 v1) { u32x4 w; w.x = cvt_pk_bf16(v0[0], v0[1]); w.y = cvt_pk_bf16(v0[2], v0[3]); w.z = cvt_pk_bf16(v1[0], v1[1]); w.w = cvt_pk_bf16(v1[2], v1[3]); *(u32x4*)p = w; }
__device__ __forceinline__ void unpack8(u32x4 w, f32x4& lo, f32x4& hi) {
    lo = (f32x4){__uint_as_float(w.x << 16), __uint_as_float(w.x & 0xffff0000u), __uint_as_float(w.y << 16), __uint_as_float(w.y & 0xffff0000u)};
    hi = (f32x4){__uint_as_float(w.z << 16), __uint_as_float(w.z & 0xffff0000u), __uint_as_float(w.w << 16), __uint_as_float(w.w & 0xffff0000u)}; }
constexpr float QSCALE = 0.125f * 1.4426950408889634f;

struct EpiProj {
    static constexpr bool PERM = true, AFTER_DRAIN = false, MID = false;
    bf16_t *GLU, *CG, *Q, *Kb, *Vb, *AG, *GT; const float* rope;
    __device__ __forceinline__ void mid(f32x4 (&acc)[2][2][4][2], const Unit& u, int wr, int wc, int fr, int fq) const {}
    __device__ __forceinline__ void operator()(const f32x4 (&acc)[2][2][4][2], const Unit& u, int wr, int wc, int fr, int fq) const {
        asm volatile("" : "+v"(fr), "+v"(fq));
        const int row0 = u.pm * BM + wr * 64 + fr, pn = u.pn, cl = wc * 32 + 8 * fq;
        if (pn < 8) {
#pragma unroll
            for (int ai = 0; ai < 2; ++ai)
#pragma unroll
                for (int m = 0; m < 4; ++m) { const size_t row = row0 + ai * HALF + m * 16;
                    const f32x4 v0 = acc[ai][0][m][0] * sig4(acc[ai][1][m][0]), v1 = acc[ai][0][m][1] * sig4(acc[ai][1][m][1]);
                    store8(GLU + row * 1024 + pn * 128 + cl, v0, v1); }
        } else if (pn >= 12 && pn < 17) {
            bf16_t* base; int ld, colbase; float sc;
            if (pn < 16) { base = Q; ld = 2048; colbase = (pn - 12) * 256 + 64 * wc; sc = QSCALE; } else { base = Kb; ld = 256; colbase = 64 * wc; sc = 1.f; }
#pragma unroll
            for (int ai = 0; ai < 2; ++ai)
#pragma unroll
                for (int m = 0; m < 4; ++m) { const size_t row = row0 + ai * HALF + m * 16; const int pos = (int)(row & 4095);
                    const f32x4* cs = (const f32x4*)(rope + (size_t)(pos * 32 + 8 * fq) * 2);
                    const f32x4 c0 = cs[0], c1 = cs[1], c2 = cs[2], c3 = cs[3];
                    const f32x4 x1a = acc[ai][0][m][0], x1b = acc[ai][0][m][1], x2a = acc[ai][1][m][0], x2b = acc[ai][1][m][1];
                    f32x4 o1a, o1b, o2a, o2b;
                    o1a[0] = (x1a[0] * c0[0] - x2a[0] * c0[1]) * sc; o2a[0] = (x2a[0] * c0[0] + x1a[0] * c0[1]) * sc;
                    o1a[1] = (x1a[1] * c0[2] - x2a[1] * c0[3]) * sc; o2a[1] = (x2a[1] * c0[2] + x1a[1] * c0[3]) * sc;
                    o1a[2] = (x1a[2] * c1[0] - x2a[2] * c1[1]) * sc; o2a[2] = (x2a[2] * c1[0] + x1a[2] * c1[1]) * sc;
                    o1a[3] = (x1a[3] * c1[2] - x2a[3] * c1[3]) * sc; o2a[3] = (x2a[3] * c1[2] + x1a[3] * c1[3]) * sc;
                    o1b[0] = (x1b[0] * c2[0] - x2b[0] * c2[1]) * sc; o2b[0] = (x2b[0] * c2[0] + x1b[0] * c2[1]) * sc;
                    o1b[1] = (x1b[1] * c2[2] - x2b[1] * c2[3]) * sc; o2b[1] = (x2b[1] * c2[2] + x1b[1] * c2[3]) * sc;
                    o1b[2] = (x1b[2] * c3[0] - x2b[2] * c3[1]) * sc; o2b[2] = (x2b[2] * c3[0] + x1b[2] * c3[1]) * sc;
                    o1b[3] = (x1b[3] * c3[2] - x2b[3] * c3[3]) * sc; o2b[3] = (x2b[3] * c3[2] + x1b[3] * c3[3]) * sc;
                    bf16_t* rp = base + row * ld + colbase + 8 * fq;
                    store8(rp, o1a, o1b); store8(rp + 32, o2a, o2b); }
        } else {
            bf16_t* base; int ld, colbase, act;
            if (pn < 12) { base = CG; ld = 1024; colbase = (pn - 8) * 256; act = 1; }
            else if (pn == 17) { base = Vb; ld = 256; colbase = 0; act = 0; }
            else if (pn < 22) { base = AG; ld = 1024; colbase = (pn - 18) * 256; act = 1; }
            else { base = GT; ld = 2048; colbase = (pn - 22) * 256; act = 2; }
#pragma unroll
            for (int ai = 0; ai < 2; ++ai)
#pragma unroll
                for (int m = 0; m < 4; ++m) { const size_t row = row0 + ai * HALF + m * 16;
#pragma unroll
                    for (int bj = 0; bj < 2; ++bj) { f32x4 v0 = acc[ai][bj][m][0], v1 = acc[ai][bj][m][1];
                        if (act) { const f32x4 s0 = sig4(v0), s1 = sig4(v1); if (act == 1) { v0 = v0 * s0; v1 = v1 * s1; } else { v0 = s0; v1 = s1; } }
                        store8(base + row * ld + colbase + bj * HALF + cl, v0, v1); } }
        }
    }
};
struct EpiMerge {
    static constexpr bool PERM = true, AFTER_DRAIN = false, MID = true;
    const bf16_t* GT; bf16_t* MG;
    __device__ __forceinline__ void mid(f32x4 (&acc)[2][2][4][2], const Unit& u, int wr, int wc, int fr, int fq) const {
        asm volatile("" : "+v"(fr), "+v"(fq));
        const int row0 = u.pm * BM + wr * 64 + fr, col0 = u.pn * BM + wc * 32 + 8 * fq;
#pragma unroll
        for (int ai = 0; ai < 2; ++ai)
#pragma unroll
            for (int m = 0; m < 4; ++m) { const size_t row = row0 + ai * HALF + m * 16;
#pragma unroll
                for (int bj = 0; bj < 2; ++bj) { const bf16_t* gp = GT + row * 2048 + col0 + bj * HALF;
                    const u32x4 wc_ = *(const u32x4*)gp, wa_ = *(const u32x4*)(gp + 1024); f32x4 c0, c1, a0, a1; unpack8(wc_, c0, c1); unpack8(wa_, a0, a1);
#pragma unroll
                    for (int i = 0; i < 4; ++i) { acc[ai][bj][m][0][i] *= c0[i] * __builtin_amdgcn_rcpf(a0[i]); acc[ai][bj][m][1][i] *= c1[i] * __builtin_amdgcn_rcpf(a1[i]); } }
                asm volatile("" : "+v"(acc[ai][0][m][0]), "+v"(acc[ai][0][m][1]), "+v"(acc[ai][1][m][0]), "+v"(acc[ai][1][m][1]));
                asm volatile("" ::: "memory"); }
    }
    __device__ __forceinline__ void operator()(const f32x4 (&acc)[2][2][4][2], const Unit& u, int wr, int wc, int fr, int fq) const {
        asm volatile("" : "+v"(fr), "+v"(fq));
        const int row0 = u.pm * BM + wr * 64 + fr, col0 = u.pn * BM + wc * 32 + 8 * fq;
#pragma unroll
        for (int ai = 0; ai < 2; ++ai)
#pragma unroll
            for (int m = 0; m < 4; ++m) { const size_t row = row0 + ai * HALF + m * 16;
#pragma unroll
                for (int bj = 0; bj < 2; ++bj) { const u32x4 wa_ = *(const u32x4*)(GT + row * 2048 + 1024 + col0 + bj * HALF); f32x4 a0, a1; unpack8(wa_, a0, a1);
                    store8(MG + row * 1024 + col0 + bj * HALF, acc[ai][bj][m][0] * a0, acc[ai][bj][m][1] * a1); }
                if (m & 1) asm volatile("" ::: "memory"); }
    }
};
struct EpiOut {
    static constexpr bool PERM = true, AFTER_DRAIN = false, MID = false;
    const float* X; float* OUT; float* SS;
    __device__ __forceinline__ void mid(f32x4 (&acc)[2][2][4][2], const Unit& u, int wr, int wc, int fr, int fq) const {}
    __device__ __forceinline__ void operator()(const f32x4 (&acc)[2][2][4][2], const Unit& u, int wr, int wc, int fr, int fq) const {
        asm volatile("" : "+v"(fr), "+v"(fq));
        const int row0 = u.pm * BM + wr * 64 + fr, col0 = u.pn * BM + wc * 32 + 8 * fq;
#pragma unroll
        for (int ai = 0; ai < 2; ++ai)
#pragma unroll
            for (int m = 0; m < 4; ++m) { const size_t row = row0 + ai * HALF + m * 16; float s = 0.f;
#pragma unroll
                for (int bj = 0; bj < 2; ++bj) { const size_t off = row * 1024 + col0 + bj * HALF;
                    const f32x4 z0 = acc[ai][bj][m][0] + *(const f32x4*)(X + off), z1 = acc[ai][bj][m][1] + *(const f32x4*)(X + off + 4);
                    *(f32x4*)(OUT + off) = z0; *(f32x4*)(OUT + off + 4) = z1;
                    s += (z0[0] * z0[0] + z0[1] * z0[1]) + (z0[2] * z0[2] + z0[3] * z0[3]) + (z1[0] * z1[0] + z1[1] * z1[1]) + (z1[2] * z1[2] + z1[3] * z1[3]); }
                s += __shfl_xor(s, 16); s += __shfl_xor(s, 32);
                if (fq == 0) SS[row * 16 + u.pn * 4 + wc] = s;
                if (m & 1) asm volatile("" ::: "memory"); }
    }
};
template <class Epi, class Sched, bool ALIGN_EPI = false, bool SP2 = false>
__device__ __forceinline__ void gemm_phase(PG8_LAS unsigned char* lds, const Gemm g, const Sched& S, const Epi& E) {
    int tid_ = threadIdx.x; asm volatile("" : "+v"(tid_));
    const int tid = tid_, wid = __builtin_amdgcn_readfirstlane(tid >> 6), lane = tid & 63, wr = wid >> 2, wc = wid & 3, fr = lane & 15, fq = lane >> 4;
    const int K = g.K, nt = K / BK;
    unsigned voffA[2], voffB[2];
#pragma unroll
    for (int i = 0; i < 2; ++i) { int R, C; stage_rc(tid * 16 + i * 8192, R, C); const int Rb = Epi::PERM ? ((R & ~31) + perm32(R & 31)) : R;
        voffA[i] = (unsigned)(R * g.lda + C) * 2u; voffB[i] = (unsigned)(Rb * K + C) * 2u; }
    const size_t kstep = (size_t)(BK * 2);
    const size_t hstep = (size_t)HALF * K * 2;
    const size_t tstep = 2 * hstep; const size_t hstepA = (size_t)HALF * g.lda * 2, tstepA = 2 * hstepA;
    const unsigned ldsw = (unsigned)wid * 1024u;
    const int aoff = lds_byte(wr * 64 + fr, fq * 8), boff = lds_byte(wc * 32 + fr, fq * 8);
#define PG8_SA(b, h) (((b) * 2 + (h)) * HTB)
#define PG8_SB(b, h) ((4 + (b) * 2 + (h)) * HTB)
#define PG8_STAGE(bufoff, gbase, voff) do { _Pragma("unroll") for (int _i = 0; _i < 2; ++_i) \
        __builtin_amdgcn_global_load_lds((const unsigned*)((const char*)(gbase) + (voff)[_i]), (PG8_LAS unsigned*)(lds + (bufoff) + ldsw + _i * 8192), 16, 0, 0); } while (0)
#define PG8_LDA(dst, b, h) do { _Pragma("unroll") for (int m = 0; m < 4; ++m) _Pragma("unroll") for (int k = 0; k < 2; ++k) dst[m][k] = *(const PG8_LAS bf16x8*)(lds + PG8_SA(b, h) + aoff + m * 2048 + k * 1024); } while (0)
#define PG8_LDB(dst, b, h) do { _Pragma("unroll") for (int n = 0; n < 2; ++n) _Pragma("unroll") for (int k = 0; k < 2; ++k) dst[n][k] = *(const PG8_LAS bf16x8*)(lds + PG8_SB(b, h) + boff + n * 2048 + k * 1024); } while (0)
#define PG8_MMA(ai, bj, At, Bt) do { __builtin_amdgcn_s_setprio(1); _Pragma("unroll") for (int m = 0; m < 4; ++m) _Pragma("unroll") for (int n = 0; n < 2; ++n) _Pragma("unroll") for (int k = 0; k < 2; ++k) \
        acc[ai][bj][m][n] = __builtin_amdgcn_mfma_f32_16x16x32_bf16(Bt[n][k], At[m][k], acc[ai][bj][m][n], 0, 0, 0); __builtin_amdgcn_s_setprio(0); } while (0)
#define PG8_WAIT_V(n) asm volatile("s_waitcnt vmcnt(" #n ")" ::: "memory")
#define PG8_WAIT_L(n) asm volatile("s_waitcnt lgkmcnt(" #n ")" ::: "memory")
#define PG8_BAR __builtin_amdgcn_s_barrier()
#define PG8_SCHED __builtin_amdgcn_sched_barrier(0)
    Unit cur, nxt; int ui = 0;
    if (!S.next(0, cur)) return;
    f32x4 acc[2][2][4][2];
#pragma unroll
    for (int a = 0; a < 2; ++a)
#pragma unroll
        for (int b = 0; b < 2; ++b)
#pragma unroll
            for (int m = 0; m < 4; ++m)
#pragma unroll
                for (int n = 0; n < 2; ++n) acc[a][b][m][n] = (f32x4){0.f, 0.f, 0.f, 0.f};
    bf16x8 At[4][2], B0[2][2], B1[2][2];
    const char* cA = (const char*)g.A + (size_t)cur.pm * tstepA; const char* cB = (const char*)g.Bt + (size_t)cur.pn * tstep;
    S.a_ready(cur);
    if constexpr (SP2) {
        PG8_STAGE(PG8_SB(0, 0), cB, voffB); PG8_STAGE(PG8_SB(0, 1), cB + hstep, voffB); PG8_STAGE(PG8_SA(0, 0), cA, voffA); PG8_STAGE(PG8_SA(0, 1), cA + hstepA, voffA);
        if (wr == 1) PG8_BAR;
        PG8_WAIT_V(2); PG8_BAR;
        PG8_STAGE(PG8_SB(1, 0), cB + kstep, voffB); PG8_STAGE(PG8_SA(1, 0), cA + kstep, voffA); PG8_STAGE(PG8_SB(1, 1), cB + hstep + kstep, voffB);
        PG8_WAIT_V(6); PG8_BAR;
    } else {
        PG8_STAGE(PG8_SB(0, 0), cB, voffB); PG8_STAGE(PG8_SA(0, 0), cA, voffA); PG8_STAGE(PG8_SB(0, 1), cB + hstep, voffB); PG8_STAGE(PG8_SA(0, 1), cA + hstepA, voffA);
        if (wr == 1) PG8_BAR;
        PG8_WAIT_V(4); PG8_BAR;
        PG8_STAGE(PG8_SB(1, 0), cB + kstep, voffB); PG8_STAGE(PG8_SA(1, 0), cA + kstep, voffA); PG8_STAGE(PG8_SB(1, 1), cB + hstep + kstep, voffB);
        PG8_WAIT_V(6); PG8_BAR;
    }
    for (;;) {
        const bool has_next = S.next(ui + 1, nxt);
        const char* nA = has_next ? (const char*)g.A + (size_t)nxt.pm * tstepA : cA; const char* nB = has_next ? (const char*)g.Bt + (size_t)nxt.pn * tstep : cB;
        for (int t = 0; t < nt; t += 2) {
            if constexpr (Epi::MID) { if (t == nt / 2) E.mid(acc, cur, wr, wc, fr, fq); }
            const bool last = (t == nt - 2);
            const char* a1 = cA + (size_t)(t + 1) * kstep;
            const char* a2 = last ? nA : cA + (size_t)(t + 2) * kstep; const char* b2 = last ? nB : cB + (size_t)(t + 2) * kstep;
            const char* a3 = a2 + kstep; const char* b3 = b2 + kstep;
            if (last && has_next) S.a_ready(nxt);
            if constexpr (SP2) {
            PG8_LDB(B0, 0, 0); PG8_LDB(B1, 0, 1); PG8_SCHED; PG8_LDA(At, 0, 0); PG8_STAGE(PG8_SA(1, 1), a1 + hstepA, voffA);
            PG8_WAIT_V(8); PG8_WAIT_L(0); PG8_BAR; PG8_MMA(0, 0, At, B0); PG8_MMA(0, 1, At, B1); PG8_BAR; PG8_SCHED;
            PG8_LDA(At, 0, 1); PG8_STAGE(PG8_SB(0, 0), b2, voffB); PG8_STAGE(PG8_SB(0, 1), b2 + hstep, voffB); PG8_STAGE(PG8_SA(0, 0), a2, voffA);
            PG8_WAIT_V(8); PG8_WAIT_L(0); PG8_BAR; PG8_MMA(1, 0, At, B0); PG8_MMA(1, 1, At, B1); PG8_BAR; PG8_SCHED;
            PG8_LDB(B0, 1, 0); PG8_LDB(B1, 1, 1); PG8_SCHED; PG8_LDA(At, 1, 0); PG8_STAGE(PG8_SA(0, 1), a2 + hstepA, voffA);
            PG8_WAIT_V(8); PG8_WAIT_L(0); PG8_BAR; PG8_MMA(0, 0, At, B0); PG8_MMA(0, 1, At, B1); PG8_BAR; PG8_SCHED;
            PG8_LDA(At, 1, 1); PG8_STAGE(PG8_SB(1, 0), b3, voffB); PG8_STAGE(PG8_SB(1, 1), b3 + hstep, voffB); PG8_STAGE(PG8_SA(1, 0), a3, voffA);
            PG8_WAIT_V(8); PG8_WAIT_L(0); PG8_BAR; PG8_MMA(1, 0, At, B0); PG8_MMA(1, 1, At, B1); PG8_BAR; PG8_SCHED;
            } else {
            PG8_LDB(B0, 0, 0); PG8_SCHED; PG8_LDA(At, 0, 0); PG8_STAGE(PG8_SA(1, 1), a1 + hstepA, voffA);
            PG8_WAIT_L(8); PG8_BAR; PG8_WAIT_L(0); PG8_MMA(0, 0, At, B0); PG8_BAR; PG8_SCHED;
            PG8_LDB(B1, 0, 1); PG8_STAGE(PG8_SB(0, 0), b2, voffB);
            PG8_BAR; PG8_WAIT_L(0); PG8_MMA(0, 1, At, B1); PG8_BAR;
            PG8_LDA(At, 0, 1); PG8_STAGE(PG8_SA(0, 0), a2, voffA);
            PG8_BAR; PG8_WAIT_L(0); PG8_MMA(1, 0, At, B0); PG8_BAR; PG8_SCHED;
            PG8_STAGE(PG8_SB(0, 1), b2 + hstep, voffB);
            PG8_WAIT_V(6); PG8_BAR; PG8_MMA(1, 1, At, B1); PG8_BAR;
            PG8_LDB(B0, 1, 0); PG8_SCHED; PG8_LDA(At, 1, 0); PG8_STAGE(PG8_SA(0, 1), a2 + hstepA, voffA);
            PG8_WAIT_L(8); PG8_BAR; PG8_WAIT_L(0); PG8_MMA(0, 0, At, B0); PG8_BAR; PG8_SCHED;
            PG8_LDB(B1, 1, 1); PG8_STAGE(PG8_SB(1, 0), b3, voffB);
            PG8_BAR; PG8_WAIT_L(0); PG8_MMA(0, 1, At, B1); PG8_BAR;
            PG8_LDA(At, 1, 1); PG8_STAGE(PG8_SA(1, 0), a3, voffA);
            PG8_BAR; PG8_WAIT_L(0); PG8_MMA(1, 0, At, B0); PG8_BAR; PG8_SCHED;
            PG8_STAGE(PG8_SB(1, 1), b3 + hstep, voffB);
            PG8_WAIT_V(6); PG8_BAR; PG8_MMA(1, 1, At, B1); PG8_BAR;
            }
        }
        if constexpr (ALIGN_EPI) { if (wr == 0) PG8_BAR; }
        if constexpr (!Epi::AFTER_DRAIN) { E(acc, cur, wr, wc, fr, fq); S.done(cur); }
        if (!has_next) break;
#pragma unroll
        for (int a = 0; a < 2; ++a)
#pragma unroll
            for (int b = 0; b < 2; ++b)
#pragma unroll
                for (int m = 0; m < 4; ++m)
#pragma unroll
                    for (int n = 0; n < 2; ++n) acc[a][b][m][n] = (f32x4){0.f, 0.f, 0.f, 0.f};
        cur = nxt; cA = nA; cB = nB; ++ui;
        if constexpr (ALIGN_EPI) { if (wr == 1) PG8_BAR; }
    }
    PG8_WAIT_V(0);
    if constexpr (!ALIGN_EPI) { if (wr == 0) PG8_BAR; }
    PG8_BAR;
    if constexpr (Epi::AFTER_DRAIN) { E.fused(acc, cur, wr, wc, fr, fq, lds, wid, lane); S.done(cur); }
#undef PG8_SA
#undef PG8_SB
#undef PG8_STAGE
#undef PG8_LDA
#undef PG8_LDB
#undef PG8_MMA
#undef PG8_WAIT_V
#undef PG8_WAIT_L
#undef PG8_BAR
#undef PG8_SCHED
}
}
#define LAS __attribute__((address_space(3)))
typedef unsigned short bf16;
typedef unsigned v4u __attribute__((ext_vector_type(4)));
typedef unsigned v2u __attribute__((ext_vector_type(2)));
typedef float f32x4 __attribute__((ext_vector_type(4)));
typedef float f32x2 __attribute__((ext_vector_type(2)));
typedef float f32x16 __attribute__((ext_vector_type(16)));
typedef short bf16x8 __attribute__((ext_vector_type(8)));
typedef short s16x4 __attribute__((ext_vector_type(4)));
using pg8::cvt_pk_bf16; using pg8::fsig;

constexpr int NWAVES = 8, NTHR = 512;
constexpr int SEQ = 4096, BATCH = 8, D = 1024, M = BATCH * SEQ, NIN = 7680;
constexpr float RMS_EPS = 1e-5f, LN_EPS = 1e-5f, LOG2E = 1.4426950408889634f;
constexpr size_t MiB = 1u << 20;
constexpr size_t WS_ROPE = 0;
constexpr size_t WS_SS = 1 * MiB;
constexpr size_t WS_W1 = 3 * MiB;
constexpr size_t WS_WCA = 18 * MiB;
constexpr size_t WS_WO = 22 * MiB;
constexpr size_t WS_U = 32 * MiB;
constexpr size_t WS_GLU = 160 * MiB;
constexpr size_t WS_CG = 224 * MiB;
constexpr size_t WS_K = 288 * MiB;
constexpr size_t WS_V = 304 * MiB;
constexpr size_t WS_AG = 320 * MiB;
constexpr size_t WS_GT = 384 * MiB;
constexpr size_t WS_BAR = 24 * MiB;
constexpr size_t WS_END = 512 * MiB;
#ifndef MK_CUTS
#define MK_CUTS {0, 6}
#endif
constexpr int CUTS[] = MK_CUTS;
constexpr int N_LAUNCHES = (int)(sizeof(CUTS) / sizeof(int)) - 1;
constexpr int LDS_BYTES = 147456;
constexpr int RING_BYTES = 131072;

__device__ __forceinline__ float wave_sum(float v) {
#pragma unroll
    for (int o = 1; o < 64; o <<= 1) v += __shfl_xor(v, o);
    return v;
}
#define LDS_WAIT() asm volatile("s_waitcnt lgkmcnt(0)" ::: "memory")

__device__ __forceinline__ void p0_transpose_item(const float* W, int N, bf16* WT, int ldo, int drow0, int kofs, LAS float* scr, int k0, int n0, int lane) {
#pragma unroll 8
    for (int i = 0; i < 32; ++i) { const int kk = 2 * i + (lane >> 5); scr[kk * 33 + (lane & 31)] = W[(size_t)(k0 + kk) * N + n0 + (lane & 31)]; }
    LDS_WAIT(); asm volatile("" ::: "memory");
    const int c = lane & 7;
#pragma unroll
    for (int j = 0; j < 4; ++j) { const int n = (lane >> 3) + 8 * j; const LAS float* s = scr + (8 * c) * 33 + n;
        v4u o; o.x = cvt_pk_bf16(s[0 * 33], s[1 * 33]); o.y = cvt_pk_bf16(s[2 * 33], s[3 * 33]); o.z = cvt_pk_bf16(s[4 * 33], s[5 * 33]); o.w = cvt_pk_bf16(s[6 * 33], s[7 * 33]);
        *(v4u*)(WT + (size_t)(drow0 + n) * ldo + kofs + k0 + 8 * c) = o; }
    LDS_WAIT(); asm volatile("" ::: "memory");
}
__device__ __forceinline__ int w1_dest_row(int n0) {
    if (n0 < 2048) { const int bj = n0 >> 10, rem = n0 & 1023; return 256 * (rem >> 7) + 128 * bj + (rem & 127); }
    if (n0 >= 3072 && n0 < 4352) { const int base = n0 < 4096 ? 3072 : 4096; const int lq = n0 - base, t = lq >> 8, l = lq & 255, head = l >> 6, bj = (l & 63) >> 5;
        return base + 256 * t + 128 * bj + 32 * head; }
    return n0;
}

struct Args { const float* in[12]; float* out; unsigned char* ws; int ph_lo, ph_hi; };

__device__ __forceinline__ void p0_prologue(const Args& a, LAS unsigned char* lds) {
    int tid = threadIdx.x; asm volatile("" : "+v"(tid)); const int lane = tid & 63, wave = __builtin_amdgcn_readfirstlane(tid >> 6);
    unsigned char* ws = a.ws;
    LAS float* scr = (LAS float*)(lds + wave * 16384);
    const int G = gridDim.x, gw = blockIdx.x * NWAVES + wave, NGW = G * NWAVES;
    constexpr int I_1 = 16 * (NIN / 32), I_S = 16 * 32;
    for (int it = gw; it < I_1 + 3 * I_S; it += NGW) {
        int r = it;
        if (r < I_1) { const int kb = r / (NIN / 32), nb = r % (NIN / 32); p0_transpose_item(a.in[2], NIN, (bf16*)(ws + WS_W1), 1024, w1_dest_row(32 * nb), 0, scr, 64 * kb, 32 * nb, lane); continue; } r -= I_1;
        const int kb = (r % I_S) / 32, nb = r % 32; const int which = r / I_S;
        if (which == 0) p0_transpose_item(a.in[7], 1024, (bf16*)(ws + WS_WCA), 2048, 32 * nb, 0, scr, 64 * kb, 32 * nb, lane);
        else if (which == 1) p0_transpose_item(a.in[9], 1024, (bf16*)(ws + WS_WCA), 2048, 32 * nb, 1024, scr, 64 * kb, 32 * nb, lane);
        else p0_transpose_item(a.in[10], 1024, (bf16*)(ws + WS_WO), 1024, 32 * nb, 0, scr, 64 * kb, 32 * nb, lane);
    }
    const float* x = a.in[0]; const float* ng = a.in[1]; bf16* U = (bf16*)(ws + WS_U);
    f32x4 gv[4];
#pragma unroll
    for (int j = 0; j < 4; ++j) gv[j] = *((const f32x4*)ng + lane + 64 * j);
    for (int m = gw; m < M; m += NGW) {
        const f32x4* xr = (const f32x4*)(x + (size_t)m * D) + lane; f32x4 v[4]; float s = 0.f;
#pragma unroll
        for (int j = 0; j < 4; ++j) { v[j] = xr[64 * j]; s += (v[j].x * v[j].x + v[j].y * v[j].y) + (v[j].z * v[j].z + v[j].w * v[j].w); }
        const float r = 1.0f / sqrtf(wave_sum(s) * (1.f / D) + RMS_EPS);
        v2u* o8 = (v2u*)(U + (size_t)m * 2048) + lane;
#pragma unroll
        for (int j = 0; j < 4; ++j) { v2u o; o.x = cvt_pk_bf16(v[j].x * r * gv[j].x, v[j].y * r * gv[j].y); o.y = cvt_pk_bf16(v[j].z * r * gv[j].z, v[j].w * r * gv[j].w); o8[64 * j] = o; }
    }
    float* rope = (float*)(ws + WS_ROPE);
    for (int e = blockIdx.x * NTHR + tid; e < SEQ * 32; e += G * NTHR) {
        const int pos = e >> 5, i = e & 31;
        const float inv = exp2f(-(float)(2 * i) * (13.287712379549449f / 64.0f));
        const float angf = (float)pos * inv;
        const double ang = (double)angf; const double kq = __builtin_rint(ang * 0.6366197723675814);
        double rr = __builtin_fma(-kq, 1.5707963267948966, ang); rr = __builtin_fma(-kq, 6.123233995736766e-17, rr);
        const double r2 = rr * rr;
        const double sn = rr * (1.0 + r2 * (-1.0 / 6 + r2 * (1.0 / 120 + r2 * (-1.0 / 5040 + r2 * (1.0 / 362880 + r2 * (-1.0 / 39916800))))));
        const double cs = 1.0 + r2 * (-0.5 + r2 * (1.0 / 24 + r2 * (-1.0 / 720 + r2 * (1.0 / 40320 + r2 * (-1.0 / 3628800 + r2 * (1.0 / 479001600))))));
        const int q = (int)kq & 3; double c, s;
        if (q == 0) { c = cs; s = sn; } else if (q == 1) { c = -sn; s = cs; } else if (q == 2) { c = -cs; s = -sn; } else { c = sn; s = -cs; }
        *(f32x2*)(rope + (size_t)e * 2) = (f32x2){(float)c, (float)s};
    }
}

__device__ __forceinline__ void conv_unit(const Args& a, LAS unsigned char* lds, int cu) {
    int tid = threadIdx.x; asm volatile("" : "+v"(tid)); const int lane = tid & 63, wave = __builtin_amdgcn_readfirstlane(tid >> 6);
    unsigned char* ws = a.ws;
    const bf16* GLU = (const bf16*)(ws + WS_GLU); const bf16* CG = (const bf16*)(ws + WS_CG); bf16* U = (bf16*)(ws + WS_U);
    const float* wdw = a.in[3]; const float* bdw = a.in[4]; const float* lg = a.in[5]; const float* lb = a.in[6];
    const int t0 = 32 * cu, sp0 = t0 & (SEQ - 1), c = 2 * tid;
    LAS float* cv = (LAS float*)lds;
    {
        f32x2 in[62];
#pragma unroll
        for (int i = 0; i < 62; ++i) { unsigned v = 0u; if (sp0 - 30 + i >= 0) v = *(const unsigned*)(GLU + (size_t)(t0 - 30 + i) * 1024 + c);
            in[i] = (f32x2){__uint_as_float(v << 16), __uint_as_float(v & 0xffff0000u)}; }
        f32x2 w[31];
#pragma unroll
        for (int j = 0; j < 31; ++j) w[j] = *(const f32x2*)(wdw + j * 1024 + c);
        const f32x2 bias = *(const f32x2*)(bdw + c);
#pragma unroll
        for (int tt = 0; tt < 32; ++tt) { f32x2 acc = bias;
#pragma unroll
            for (int j = 0; j < 31; ++j) acc = w[j] * in[tt + j] + acc;
            *(LAS f32x2*)(cv + tt * 1024 + c) = acc; }
    }
    __syncthreads();
#pragma unroll 1
    for (int rr = 0; rr < 4; ++rr) { const int tt = wave + 8 * rr; const size_t row = (size_t)t0 + tt;
        f32x4 v[4]; float s = 0.f;
#pragma unroll
        for (int j = 0; j < 4; ++j) { v[j] = *(const LAS f32x4*)(cv + tt * 1024 + 4 * lane + 256 * j); s += (v[j].x + v[j].y) + (v[j].z + v[j].w); }
        const float mean = wave_sum(s) * (1.f / 1024); float s2 = 0.f;
#pragma unroll
        for (int j = 0; j < 4; ++j) { v[j] = v[j] - mean; s2 += (v[j].x * v[j].x + v[j].y * v[j].y) + (v[j].z * v[j].z + v[j].w * v[j].w); }
        const float rstd = 1.0f / sqrtf(wave_sum(s2) * (1.f / 1024) + LN_EPS);
#pragma unroll
        for (int j = 0; j < 4; ++j) { const int col = 4 * lane + 256 * j;
            const f32x4 g4 = *(const f32x4*)(lg + col), b4 = *(const f32x4*)(lb + col); const v2u cg = *(const v2u*)(CG + row * 1024 + col);
            f32x4 y = v[j] * rstd * g4 + b4;
            y.x *= fsig(y.x) * __uint_as_float(cg.x << 16); y.y *= fsig(y.y) * __uint_as_float(cg.x & 0xffff0000u);
            y.z *= fsig(y.z) * __uint_as_float(cg.y << 16); y.w *= fsig(y.w) * __uint_as_float(cg.y & 0xffff0000u);
            v2u o; o.x = cvt_pk_bf16(y.x, y.y); o.y = cvt_pk_bf16(y.z, y.w); *(v2u*)(U + row * 2048 + col) = o; }
    }
    __syncthreads();
}

constexpr int KS_STRIDE = 144, VS_STRIDE = 192, VS_OFF = 256 * KS_STRIDE;
__device__ __forceinline__ int crow(int r, int hi) { return (r & 3) + 8 * (r >> 2) + 4 * hi; }
__device__ __forceinline__ void attn_unit(const Args& a, LAS unsigned char* lds, int au) {
    int tid = threadIdx.x; asm volatile("" : "+v"(tid)); const int lane = tid & 63, wave = __builtin_amdgcn_readfirstlane(tid >> 6);
    unsigned char* ws = a.ws;
    bf16* U = (bf16*)(ws + WS_U); const bf16* Kb = (const bf16*)(ws + WS_K); const bf16* Vb = (const bf16*)(ws + WS_V); const bf16* AG = (const bf16*)(ws + WS_AG);
    const int b = au >> 7, nb = (au >> 2) & 31, g = au & 3;
    const long R0 = (long)b * SEQ + 128 * nb;
#pragma unroll
    for (int i = 0; i < 4; ++i) { const int ch = tid + NTHR * i, key = ch >> 3, c8 = ch & 7; v4u kv = (v4u){0u, 0u, 0u, 0u}, vv = kv;
        if (nb > 0 || key >= 128) { const size_t off = (size_t)(R0 - 128 + key) * 256 + 64 * g + 8 * c8; kv = *(const v4u*)(Kb + off); vv = *(const v4u*)(Vb + off); }
        *(LAS v4u*)(lds + key * KS_STRIDE + c8 * 16) = kv; *(LAS v4u*)(lds + VS_OFF + key * VS_STRIDE + c8 * 16) = vv; }
    __syncthreads();
    const int hq = wave >> 1, head = 4 * g + hq, ql = lane & 31, hi = lane >> 5;
    const float sk2 = a.in[8][head] * LOG2E;
#pragma unroll 1
    for (int st = 0; st < 2; ++st) {
        const int q0 = 64 * (wave & 1) + 32 * st;
        const size_t qrow = (size_t)(R0 + q0 + ql);
        bf16* qp = U + qrow * 2048 + 1024 + 64 * head;
        bf16x8 qf[4];
#pragma unroll
        for (int kk = 0; kk < 4; ++kk) qf[kk] = *(const bf16x8*)(qp + 16 * kk + 8 * hi);
        f32x16 s[5];
#pragma unroll
        for (int j = 0; j < 5; ++j) {
            s[j] = (f32x16){};
#pragma unroll
            for (int kk = 0; kk < 4; ++kk) { const bf16x8 kf = *(const LAS bf16x8*)(lds + (q0 + 32 * j + ql) * KS_STRIDE + (16 * kk + 8 * hi) * 2);
                s[j] = __builtin_amdgcn_mfma_f32_32x32x16_bf16(kf, qf[kk], s[j], 0, 0, 0); }
        }
        float mx = sk2;
#pragma unroll
        for (int j = 0; j < 5; ++j)
#pragma unroll
            for (int r = 0; r < 16; ++r) { const int cr = crow(r, hi); bool ok = true;
                if (j == 0) ok = cr > ql; if (j == 4) ok = cr <= ql;
                if (nb == 0) ok = ok && (q0 + 32 * j + cr >= 128);
                const float v = ok ? s[j][r] : -1e30f; s[j][r] = v; mx = fmaxf(mx, v); }
        mx = fmaxf(mx, __shfl_xor(mx, 32));
        float l = 0.f;
#pragma unroll
        for (int j = 0; j < 5; ++j)
#pragma unroll
            for (int r = 0; r < 16; ++r) { const float p = __builtin_amdgcn_exp2f(s[j][r] - mx); s[j][r] = p; l += p; }
        l += __shfl_xor(l, 32);
        l += __builtin_amdgcn_exp2f(sk2 - mx);
        const float rl = 1.0f / l;
        f32x16 o[2]; o[0] = (f32x16){}; o[1] = (f32x16){};
        const int g4 = lane >> 4, li = lane & 15;
        const int vbase = VS_OFF + (q0 + 4 * (g4 >> 1) + (li >> 2)) * VS_STRIDE + (16 * (g4 & 1) + 4 * (li & 3)) * 2;
#pragma unroll
        for (int j = 0; j < 5; ++j)
#pragma unroll
            for (int s2 = 0; s2 < 2; ++s2) {
                v4u pw; pw.x = cvt_pk_bf16(s[j][8 * s2 + 0], s[j][8 * s2 + 1]); pw.y = cvt_pk_bf16(s[j][8 * s2 + 2], s[j][8 * s2 + 3]);
                pw.z = cvt_pk_bf16(s[j][8 * s2 + 4], s[j][8 * s2 + 5]); pw.w = cvt_pk_bf16(s[j][8 * s2 + 6], s[j][8 * s2 + 7]);
                const bf16x8 pf = __builtin_bit_cast(bf16x8, pw);
#pragma unroll
                for (int dt = 0; dt < 2; ++dt) {
                    const int ad = vbase + (32 * j + 16 * s2) * VS_STRIDE + 64 * dt;
                    const s16x4 lo = __builtin_bit_cast(s16x4, __builtin_amdgcn_ds_read_tr16_b64_v4i16((LAS s16x4*)(lds + ad)));
                    const s16x4 h4 = __builtin_bit_cast(s16x4, __builtin_amdgcn_ds_read_tr16_b64_v4i16((LAS s16x4*)(lds + ad + 8 * VS_STRIDE)));
                    const bf16x8 vf = (bf16x8){lo[0], lo[1], lo[2], lo[3], h4[0], h4[1], h4[2], h4[3]};
                    o[dt] = __builtin_amdgcn_mfma_f32_32x32x16_bf16(vf, pf, o[dt], 0, 0, 0);
                }
            }
        const bf16* agp = AG + qrow * 1024 + 64 * head;
#pragma unroll
        for (int dt = 0; dt < 2; ++dt)
#pragma unroll
            for (int r4 = 0; r4 < 4; ++r4) { const int d = 32 * dt + 8 * r4 + 4 * hi; const v2u gq = *(const v2u*)(agp + d);
                v2u w; w.x = cvt_pk_bf16(o[dt][4 * r4 + 0] * rl * __uint_as_float(gq.x << 16), o[dt][4 * r4 + 1] * rl * __uint_as_float(gq.x & 0xffff0000u));
                w.y = cvt_pk_bf16(o[dt][4 * r4 + 2] * rl * __uint_as_float(gq.y << 16), o[dt][4 * r4 + 3] * rl * __uint_as_float(gq.y & 0xffff0000u));
                *(v2u*)(qp + d) = w; }
    }
    __syncthreads();
}

#define GRID_SYNC() do { asm volatile("s_waitcnt vmcnt(0) lgkmcnt(0)" ::: "memory"); __builtin_amdgcn_fence(__ATOMIC_RELEASE, "agent"); asm volatile("s_waitcnt vmcnt(0)" ::: "memory"); \
    grid.sync(); __builtin_amdgcn_fence(__ATOMIC_ACQUIRE, "agent"); asm volatile("s_waitcnt vmcnt(0)" ::: "memory"); __syncthreads(); } while (0)
__device__ __forceinline__ void my_grid_barrier(unsigned* ctr, unsigned& epoch, unsigned G) {
    asm volatile("s_waitcnt vmcnt(0) lgkmcnt(0)" ::: "memory");
    __syncthreads();
    epoch += G;
    if (threadIdx.x == 0) {
        __builtin_amdgcn_fence(__ATOMIC_RELEASE, "agent"); asm volatile("s_waitcnt vmcnt(0)" ::: "memory");
        __hip_atomic_fetch_add(ctr, 1u, __ATOMIC_RELAXED, __HIP_MEMORY_SCOPE_AGENT);
        while (__hip_atomic_load(ctr, __ATOMIC_RELAXED, __HIP_MEMORY_SCOPE_AGENT) < epoch) __builtin_amdgcn_s_sleep(1);
        __builtin_amdgcn_fence(__ATOMIC_ACQUIRE, "agent"); asm volatile("s_waitcnt vmcnt(0)" ::: "memory");
    }
    __syncthreads();
}
__global__ void __launch_bounds__(NTHR, 2) mega_fwd(Args args) {
    extern __shared__ __attribute__((aligned(16))) unsigned char lds_raw[];
    cg::grid_group grid = cg::this_grid();
    LAS unsigned char* lds = (LAS unsigned char*)lds_raw;
    unsigned char* ws = args.ws;
    const int G = gridDim.x;
    const int lo = args.ph_lo, hi = args.ph_hi;
#define IN(k) (lo <= (k) && (k) < hi)
#define SEAM(k) do { if (IN(k) && IN((k) + 1)) GRID_SYNC(); } while (0)
    if (IN(0)) p0_prologue(args, lds);
    SEAM(0);
    if (IN(1)) {
        pg8::Gemm g{(const pg8::bf16_t*)(ws + WS_U), (const pg8::bf16_t*)(ws + WS_W1), M, NIN, D, 2048};
        pg8::StaticOrder S; S.init(M, NIN, G, (int)blockIdx.x);
        pg8::EpiProj E{(bf16*)(ws + WS_GLU), (bf16*)(ws + WS_CG), (bf16*)(ws + WS_U) + 1024, (bf16*)(ws + WS_K), (bf16*)(ws + WS_V), (bf16*)(ws + WS_AG), (bf16*)(ws + WS_GT), (const float*)(ws + WS_ROPE)};
        pg8::gemm_phase<pg8::EpiProj, pg8::StaticOrder, true, true>(lds, g, S, E);
    }
    SEAM(1);
    if (IN(2)) {
        for (int u = blockIdx.x; u < 1024; u += G) attn_unit(args, lds, u);
        for (int u = blockIdx.x; u < 1024; u += G) conv_unit(args, lds, u);
    }
    SEAM(2);
    if (IN(3)) {
        pg8::Gemm g{(const pg8::bf16_t*)(ws + WS_U), (const pg8::bf16_t*)(ws + WS_WCA), M, D, 2048, 2048};
        pg8::StaticOrder S; S.init(M, D, G, (int)blockIdx.x);
        pg8::EpiMerge E{(const bf16*)(ws + WS_GT), (bf16*)(ws + WS_GLU)};
        pg8::gemm_phase<pg8::EpiMerge, pg8::StaticOrder, true, true>(lds, g, S, E);
    }
    SEAM(3);
    if (IN(4)) {
        pg8::Gemm g{(const pg8::bf16_t*)(ws + WS_GLU), (const pg8::bf16_t*)(ws + WS_WO), M, D, D, 1024};
        pg8::StaticOrder S; S.init(M, D, G, (int)blockIdx.x);
        pg8::EpiOut E{args.in[0], args.out, (float*)(ws + WS_SS)};
        pg8::gemm_phase<pg8::EpiOut, pg8::StaticOrder, true, true>(lds, g, S, E);
    }
    SEAM(4);
    if (IN(5)) {
        int tid = threadIdx.x; asm volatile("" : "+v"(tid)); const int lane = tid & 63, wave = __builtin_amdgcn_readfirstlane(tid >> 6);
        const float* SS = (const float*)(ws + WS_SS); const float* fg = args.in[11]; float* out = args.out;
        f32x4 gv[4];
#pragma unroll
        for (int j = 0; j < 4; ++j) gv[j] = *((const f32x4*)fg + lane + 64 * j);
        for (int m = blockIdx.x * NWAVES + wave; m < M; m += G * NWAVES) {
            float s = SS[(size_t)m * 16 + (lane & 15)];
            s += __shfl_xor(s, 1); s += __shfl_xor(s, 2); s += __shfl_xor(s, 4); s += __shfl_xor(s, 8);
            const float r = 1.0f / sqrtf(s * (1.f / D) + RMS_EPS);
            f32x4* orow = (f32x4*)(out + (size_t)m * D) + lane;
#pragma unroll
            for (int j = 0; j < 4; ++j) { f32x4 v = orow[64 * j]; orow[64 * j] = v * r * gv[j]; }
        }
    }
#if defined(MK_DUMP)
    if (lo == 7) {
        int tid = threadIdx.x; const int lane = tid & 63, wave = tid >> 6; float* out = args.out;
        const bf16 *GLUp = (const bf16*)(ws + WS_GLU), *CGp = (const bf16*)(ws + WS_CG), *AGp = (const bf16*)(ws + WS_AG), *Up = (const bf16*)(ws + WS_U), *GTp = (const bf16*)(ws + WS_GT), *Kp = (const bf16*)(ws + WS_K), *Vp = (const bf16*)(ws + WS_V);
        for (int m = blockIdx.x * NWAVES + wave; m < M; m += G * NWAVES)
            for (int c = lane; c < 1024; c += 64) { float v = 0.f;
#define BF(p_) __uint_as_float((unsigned)(p_) << 16)
                if (MK_DUMP == 1) v = BF(Up[(size_t)m * 2048 + c]) + ((const float*)(ws + WS_ROPE))[(size_t)(m & 4095) * 64 + (c & 63)] + BF(((const bf16*)(ws + WS_W1))[(size_t)(m % 7680) * 1024 + c]) + BF(((const bf16*)(ws + WS_WCA))[(size_t)(m & 1023) * 2048 + c]) + BF(((const bf16*)(ws + WS_WCA))[(size_t)(m & 1023) * 2048 + 1024 + c]) + BF(((const bf16*)(ws + WS_WO))[(size_t)(m & 1023) * 1024 + c]);
                if (MK_DUMP == 2) v = BF(GLUp[(size_t)m * 1024 + c]) + BF(CGp[(size_t)m * 1024 + c]) + BF(AGp[(size_t)m * 1024 + c]) + BF(Up[(size_t)m * 2048 + 1024 + c]) + BF(GTp[(size_t)m * 2048 + c]) + BF(GTp[(size_t)m * 2048 + 1024 + c]) + BF(Kp[(size_t)m * 256 + (c & 255)]) + BF(Vp[(size_t)m * 256 + (c & 255)]);
                if (MK_DUMP == 21) v = BF(GLUp[(size_t)m * 1024 + c]) + BF(CGp[(size_t)m * 1024 + c]) + BF(AGp[(size_t)m * 1024 + c]) + BF(GTp[(size_t)m * 2048 + c]) + BF(GTp[(size_t)m * 2048 + 1024 + c]);
                if (MK_DUMP == 22) v = BF(Up[(size_t)m * 2048 + 1024 + c]) + BF(Kp[(size_t)m * 256 + (c & 255)]) + BF(Vp[(size_t)m * 256 + (c & 255)]);
                if (MK_DUMP == 3) v = BF(Up[(size_t)m * 2048 + c]) + BF(Up[(size_t)m * 2048 + 1024 + c]);
                if (MK_DUMP == 4) v = BF(GLUp[(size_t)m * 1024 + c]);
                if (MK_DUMP == 5) v = out[(size_t)m * 1024 + c] + ((const float*)(ws + WS_SS))[(size_t)m * 16 + (c & 15)];
                out[(size_t)m * 1024 + c] = v; }
    }
#endif
#undef IN
#undef SEAM
}

extern "C" void kernel_launch(void* const* d_in, const int* in_sizes, int n_in, void* d_out, int out_size, void* d_ws, size_t ws_size, hipStream_t stream) {
    static int grid = 0;
    if (grid == 0) {
        if (n_in != 12 || in_sizes[0] != M * D || out_size != M * D || ws_size < WS_END) { fprintf(stderr, "kernel_launch: unexpected shapes (n_in %d, in0 %d, out %d, ws %zu)\n", n_in, n_in > 0 ? in_sizes[0] : -1, out_size, ws_size); grid = -1; return; }
        int dev = 0, cus = 0, per_cu = 0;
        if (hipGetDevice(&dev) != hipSuccess || hipDeviceGetAttribute(&cus, hipDeviceAttributeMultiprocessorCount, dev) != hipSuccess) { grid = -1; return; }
        if (hipFuncSetAttribute((const void*)mega_fwd, hipFuncAttributeMaxDynamicSharedMemorySize, LDS_BYTES) != hipSuccess) { fprintf(stderr, "kernel_launch: hipFuncSetAttribute failed\n"); grid = -1; return; }
        if (hipOccupancyMaxActiveBlocksPerMultiprocessor(&per_cu, (const void*)mega_fwd, NTHR, LDS_BYTES) != hipSuccess || per_cu < 1) { fprintf(stderr, "kernel_launch: occupancy query failed (%d)\n", per_cu); grid = -1; return; }
        grid = cus * per_cu;
        fprintf(stderr, "kernel_launch: grid %d (%d CUs x %d)\n", grid, cus, per_cu);
    }
    if (grid < 0) return;
    Args a{};
    for (int i = 0; i < 12; ++i) a.in[i] = (const float*)d_in[i];
    a.out = (float*)d_out; a.ws = (unsigned char*)d_ws;
    for (int li = 0; li < N_LAUNCHES; ++li) {
        a.ph_lo = CUTS[li]; a.ph_hi = CUTS[li + 1];
        void* kargs[] = {&a};
        hipError_t e = hipLaunchCooperativeKernel((const void*)mega_fwd, dim3(grid), dim3(NTHR), kargs, LDS_BYTES, stream);
        if (e != hipSuccess) { fprintf(stderr, "kernel_launch: cooperative launch failed: %s (grid %d)\n", hipGetErrorString(e), grid); break; }
    }
#if defined(MK_DUMP)
    { a.ph_lo = 7; a.ph_hi = 8; void* kargs[] = {&a}; (void)hipLaunchCooperativeKernel((const void*)mega_fwd, dim3(grid), dim3(NTHR), kargs, LDS_BYTES, stream); }
#endif
}
```

```cpp
#include <hip/hip_runtime.h>
#include <hip/hip_cooperative_groups.h>
#include <cstdio>
#include <cstdint>
namespace cg = cooperative_groups;
namespace pg8 {
#define PG8_LAS __attribute__((address_space(3)))
typedef unsigned short bf16_t;
typedef short bf16x8 __attribute__((ext_vector_type(8)));
typedef float f32x4 __attribute__((ext_vector_type(4)));
typedef unsigned u32x4 __attribute__((ext_vector_type(4)));
constexpr int BM = 256, BK = 64, HALF = 128, HTB = HALF * BK * 2  , STAGE_BYTES = 8 * HTB, NXCD = 8, WGM = 8;

__host__ __device__ __forceinline__ int lds_byte(int r, int c) { const int st = (r >> 4) * 2 + (c >> 5), rr = r & 15, cc = c & 31, ob = rr * 64 + cc * 2; return st * 1024 + (ob ^ (((ob >> 9) & 1) << 5)); }
__host__ __device__ __forceinline__ void stage_rc(int b, int& R, int& C) { const int st = b / 1024, sb = b % 1024, swz = sb ^ (((sb >> 9) & 1) << 5); R = (st >> 1) * 16 + swz / 64; C = (st & 1) * 32 + (swz % 64) / 2; }
__host__ __device__ __forceinline__ int perm32(int rho) { const int n = rho >> 4, i = rho & 15; return 8 * (i >> 2) + 4 * n + (i & 3); }

struct Unit { int pm, pn; };
struct Gemm { const bf16_t* A; const bf16_t* Bt; int M, N, K, lda; };

struct StaticOrder {
    int nM, nN, nwg, G, c;
    __host__ __device__ void init(int M, int N, int G_, int c_) { nM = M / BM; nN = N / BM; nwg = nM * nN; G = G_; c = c_; }
    __host__ __device__ bool next(int i, Unit& u) const {
        const long L = (long)i * G + c; if (L >= nwg) return false;
        int wgid = (int)L; { const int q = nwg / NXCD, r = nwg % NXCD, xcd = wgid % NXCD, off = wgid / NXCD; wgid = (xcd < r ? xcd * (q + 1) : r * (q + 1) + (xcd - r) * q) + off; }
        const int nig = WGM * nN, gid = wgid / nig, fm = gid * WGM, gsz = (nM - fm) < WGM ? (nM - fm) : WGM;
        u.pm = fm + ((wgid % nig) % gsz); u.pn = (wgid % nig) / gsz; return true;
    }
    __device__ __forceinline__ void a_ready(const Unit&) const {}
    __device__ __forceinline__ void done(const Unit&) const {}
};


typedef float f32x2_t __attribute__((ext_vector_type(2))); typedef __bf16 bf16x2_t __attribute__((ext_vector_type(2)));
__device__ __forceinline__ unsigned cvt_pk_bf16(float lo, float hi) { f32x2_t v = {lo, hi}; bf16x2_t b = __builtin_convertvector(v, bf16x2_t); return __builtin_bit_cast(unsigned, b); }
__device__ __forceinline__ float fsig(float x) { return __builtin_amdgcn_rcpf(1.f + __builtin_amdgcn_exp2f(-1.4426950408889634f * x)); }
__device__ __forceinline__ f32x4 sig4(f32x4 v) { return (f32x4){fsig(v[0]), fsig(v[1]), fsig(v[2]), fsig(v[3])}; }
__device__ __forceinline__ void store8(bf16_t* p, f32x4 v0, f32x4 v1) { u32x4 w; w.x = cvt_pk_bf16(v0[0], v0[1]); w.y = cvt_pk_bf16(v0[2], v0[3]); w.z = cvt_pk_bf16(v1[0], v1[1]); w.w = cvt_pk_bf16(v1[2], v1[3]); *(u32x4*)p = w; }
__device__ __forceinline__ void unpack8(u32x4 w, f32x4& lo, f32x4& hi) {
    lo = (f32x4){__uint_as_float(w.x << 16), __uint_as_float(w.x & 0xffff0000u), __uint_as_float(w.y << 16), __uint_as_float(w.y & 0xffff0000u)};
    hi = (f32x4){__uint_as_float(w.z << 16), __uint_as_float(w.z & 0xffff0000u), __uint_as_float(w.w << 16), __uint_as_float(w.w & 0xffff0000u)}; }
constexpr float QSCALE = 0.125f * 1.4426950408889634f;

struct EpiProj {
    static constexpr bool PERM = true, AFTER_DRAIN = false, MID = false;
    bf16_t *GLU, *CG, *Q, *Kb, *Vb, *AG, *GT; const float* rope;
    __device__ __forceinline__ void mid(f32x4 (&acc)[2][2][4][2], const Unit& u, int wr, int wc, int fr, int fq) const {}
    __device__ __forceinline__ void operator()(const f32x4 (&acc)[2][2][4][2], const Unit& u, int wr, int wc, int fr, int fq) const {
        asm volatile("" : "+v"(fr), "+v"(fq));
        const int row0 = u.pm * BM + wr * 64 + fr, pn = u.pn, cl = wc * 32 + 8 * fq;
        if (pn < 8) {
#pragma unroll
            for (int ai = 0; ai < 2; ++ai)
#pragma unroll
                for (int m = 0; m < 4; ++m) { const size_t row = row0 + ai * HALF + m * 16;
                    const f32x4 v0 = acc[ai][0][m][0] * sig4(acc[ai][1][m][0]), v1 = acc[ai][0][m][1] * sig4(acc[ai][1][m][1]);
                    store8(GLU + row * 1024 + pn * 128 + cl, v0, v1); }
        } else if (pn >= 12 && pn < 17) {
            bf16_t* base; int ld, colbase; float sc;
            if (pn < 16) { base = Q; ld = 2048; colbase = (pn - 12) * 256 + 64 * wc; sc = QSCALE; } else { base = Kb; ld = 256; colbase = 64 * wc; sc = 1.f; }
#pragma unroll
            for (int ai = 0; ai < 2; ++ai)
#pragma unroll
                for (int m = 0; m < 4; ++m) { const size_t row = row0 + ai * HALF + m * 16; const int pos = (int)(row & 4095);
                    const f32x4* cs = (const f32x4*)(rope + (size_t)(pos * 32 + 8 * fq) * 2);
                    const f32x4 c0 = cs[0], c1 = cs[1], c2 = cs[2], c3 = cs[3];
                    const f32x4 x1a = acc[ai][0][m][0], x1b = acc[ai][0][m][1], x2a = acc[ai][1][m][0], x2b = acc[ai][1][m][1];
                    f32x4 o1a, o1b, o2a, o2b;
                    o1a[0] = (x1a[0] * c0[0] - x2a[0] * c0[1]) * sc; o2a[0] = (x2a[0] * c0[0] + x1a[0] * c0[1]) * sc;
                    o1a[1] = (x1a[1] * c0[2] - x2a[1] * c0[3]) * sc; o2a[1] = (x2a[1] * c0[2] + x1a[1] * c0[3]) * sc;
                    o1a[2] = (x1a[2] * c1[0] - x2a[2] * c1[1]) * sc; o2a[2] = (x2a[2] * c1[0] + x1a[2] * c1[1]) * sc;
                    o1a[3] = (x1a[3] * c1[2] - x2a[3] * c1[3]) * sc; o2a[3] = (x2a[3] * c1[2] + x1a[3] * c1[3]) * sc;
                    o1b[0] = (x1b[0] * c2[0] - x2b[0] * c2[1]) * sc; o2b[0] = (x2b[0] * c2[0] + x1b[0] * c2[1]) * sc;
                    o1b[1] = (x1b[1] * c2[2] - x2b[1] * c2[3]) * sc; o2b[1] = (x2b[1] * c2[2] + x1b[1] * c2[3]) * sc;
                    o1b[2] = (x1b[2] * c3[0] - x2b[2] * c3[1]) * sc; o2b[2] = (x2b[2] * c3[0] + x1b[2] * c3[1]) * sc;
                    o1b[3] = (x1b[3] * c3[2] - x2b[3] * c3[3]) * sc; o2b[3] = (x2b[3] * c3[2] + x1b[3] * c3[3]) * sc;
                    bf16_t* rp = base + row * ld + colbase + 8 * fq;
                    store8(rp, o1a, o1b); store8(rp + 32, o2a, o2b); }
        } else {
            bf16_t* base; int ld, colbase, act;
            if (pn < 12) { base = CG; ld = 1024; colbase = (pn - 8) * 256; act = 1; }
            else if (pn == 17) { base = Vb; ld = 256; colbase = 0; act = 0; }
            else if (pn < 22) { base = AG; ld = 1024; colbase = (pn - 18) * 256; act = 1; }
            else { base = GT; ld = 2048; colbase = (pn - 22) * 256; act = 2; }
#pragma unroll
            for (int ai = 0; ai < 2; ++ai)
#pragma unroll
                for (int m = 0; m < 4; ++m) { const size_t row = row0 + ai * HALF + m * 16;
#pragma unroll
                    for (int bj = 0; bj < 2; ++bj) { f32x4 v0 = acc[ai][bj][m][0], v1 = acc[ai][bj][m][1];
                        if (act) { const f32x4 s0 = sig4(v0), s1 = sig4(v1); if (act == 1) { v0 = v0 * s0; v1 = v1 * s1; } else { v0 = s0; v1 = s1; } }
                        store8(base + row * ld + colbase + bj * HALF + cl, v0, v1); } }
        }
    }
};
struct EpiMerge {
    static constexpr bool PERM = true, AFTER_DRAIN = false, MID = true;
    const bf16_t* GT; bf16_t* MG;
    __device__ __forceinline__ void mid(f32x4 (&acc)[2][2][4][2], const Unit& u, int wr, int wc, int fr, int fq) const {
        asm volatile("" : "+v"(fr), "+v"(fq));
        const int row0 = u.pm * BM + wr * 64 + fr, col0 = u.pn * BM + wc * 32 + 8 * fq;
#pragma unroll
        for (int ai = 0; ai < 2; ++ai)
#pragma unroll
            for (int m = 0; m < 4; ++m) { const size_t row = row0 + ai * HALF + m * 16;
#pragma unroll
                for (int bj = 0; bj < 2; ++bj) { const bf16_t* gp = GT + row * 2048 + col0 + bj * HALF;
                    const u32x4 wc_ = *(const u32x4*)gp, wa_ = *(const u32x4*)(gp + 1024); f32x4 c0, c1, a0, a1; unpack8(wc_, c0, c1); unpack8(wa_, a0, a1);
#pragma unroll
                    for (int i = 0; i < 4; ++i) { acc[ai][bj][m][0][i] *= c0[i] * __builtin_amdgcn_rcpf(a0[i]); acc[ai][bj][m][1][i] *= c1[i] * __builtin_amdgcn_rcpf(a1[i]); } }
                asm volatile("" : "+v"(acc[ai][0][m][0]), "+v"(acc[ai][0][m][1]), "+v"(acc[ai][1][m][0]), "+v"(acc[ai][1][m][1]));
                asm volatile("" ::: "memory"); }
    }
    __device__ __forceinline__ void operator()(const f32x4 (&acc)[2][2][4][2], const Unit& u, int wr, int wc, int fr, int fq) const {
        asm volatile("" : "+v"(fr), "+v"(fq));
        const int row0 = u.pm * BM + wr * 64 + fr, col0 = u.pn * BM + wc * 32 + 8 * fq;
#pragma unroll
        for (int ai = 0; ai < 2; ++ai)
#pragma unroll
            for (int m = 0; m < 4; ++m) { const size_t row = row0 + ai * HALF + m * 16;
#pragma unroll
                for (int bj = 0; bj < 2; ++bj) { const u32x4 wa_ = *(const u32x4*)(GT + row * 2048 + 1024 + col0 + bj * HALF); f32x4 a0, a1; unpack8(wa_, a0, a1);
                    store8(MG + row * 1024 + col0 + bj * HALF, acc[ai][bj][m][0] * a0, acc[ai][bj][m][1] * a1); }
                if (m & 1) asm volatile("" ::: "memory"); }
    }
};
struct EpiOut {
    static constexpr bool PERM = true, AFTER_DRAIN = false, MID = false;
    const float* X; float* OUT; float* SS;
    __device__ __forceinline__ void mid(f32x4 (&acc)[2][2][4][2], const Unit& u, int wr, int wc, int fr, int fq) const {}
    __device__ __forceinline__ void operator()(const f32x4 (&acc)[2][2][4][2], const Unit& u, int wr, int wc, int fr, int fq) const {
        asm volatile("" : "+v"(fr), "+v"(fq));
        const int row0 = u.pm * BM + wr * 64 + fr, col0 = u.pn * BM + wc * 32 + 8 * fq;
#pragma unroll
        for (int ai = 0; ai < 2; ++ai)
#pragma unroll
            for (int m = 0; m < 4; ++m) { const size_t row = row0 + ai * HALF + m * 16; float s = 0.f;
#pragma unroll
                for (int bj = 0; bj < 2; ++bj) { const size_t off = row * 1024 + col0 + bj * HALF;
                    const f32x4 z0 = acc[ai][bj][m][0] + *(const f32x4*)(X + off), z1 = acc[ai][bj][m][1] + *(const f32x4*)(X + off + 4);
                    *(f32x4*)(OUT + off) = z0; *(f32x4*)(OUT + off + 4) = z1;
                    s += (z0[0] * z0[0] + z0[1] * z0[1]) + (z0[2] * z0[2] + z0[3] * z0[3]) + (z1[0] * z1[0] + z1[1] * z1[1]) + (z1[2] * z1[2] + z1[3] * z1[3]); }
                s += __shfl_xor(s, 16); s += __shfl_xor(s, 32);
                if (fq == 0) SS[row * 16 + u.pn * 4 + wc] = s;
                if (m & 1) asm volatile("" ::: "memory"); }
    }
};
template <class Epi, class Sched, bool ALIGN_EPI = false, bool SP2 = false>
__device__ __forceinline__ void gemm_phase(PG8_LAS unsigned char* lds, const Gemm g, const Sched& S, const Epi& E) {
    int tid_ = threadIdx.x; asm volatile("" : "+v"(tid_));
    const int tid = tid_, wid = __builtin_amdgcn_readfirstlane(tid >> 6), lane = tid & 63, wr = wid >> 2, wc = wid & 3, fr = lane & 15, fq = lane >> 4;
    const int K = g.K, nt = K / BK;
    unsigned voffA[2], voffB[2];
#pragma unroll
    for (int i = 0; i < 2; ++i) { int R, C; stage_rc(tid * 16 + i * 8192, R, C); const int Rb = Epi::PERM ? ((R & ~31) + perm32(R & 31)) : R;
        voffA[i] = (unsigned)(R * g.lda + C) * 2u; voffB[i] = (unsigned)(Rb * K + C) * 2u; }
    const size_t kstep = (size_t)(BK * 2);
    const size_t hstep = (size_t)HALF * K * 2;
    const size_t tstep = 2 * hstep; const size_t hstepA = (size_t)HALF * g.lda * 2, tstepA = 2 * hstepA;
    const unsigned ldsw = (unsigned)wid * 1024u;
    const int aoff = lds_byte(wr * 64 + fr, fq * 8), boff = lds_byte(wc * 32 + fr, fq * 8);
#define PG8_SA(b, h) (((b) * 2 + (h)) * HTB)
#define PG8_SB(b, h) ((4 + (b) * 2 + (h)) * HTB)
#define PG8_STAGE(bufoff, gbase, voff) do { _Pragma("unroll") for (int _i = 0; _i < 2; ++_i) \
        __builtin_amdgcn_global_load_lds((const unsigned*)((const char*)(gbase) + (voff)[_i]), (PG8_LAS unsigned*)(lds + (bufoff) + ldsw + _i * 8192), 16, 0, 0); } while (0)
#define PG8_LDA(dst, b, h) do { _Pragma("unroll") for (int m = 0; m < 4; ++m) _Pragma("unroll") for (int k = 0; k < 2; ++k) dst[m][k] = *(const PG8_LAS bf16x8*)(lds + PG8_SA(b, h) + aoff + m * 2048 + k * 1024); } while (0)
#define PG8_LDB(dst, b, h) do { _Pragma("unroll") for (int n = 0; n < 2; ++n) _Pragma("unroll") for (int k = 0; k < 2; ++k) dst[n][k] = *(const PG8_LAS bf16x8*)(lds + PG8_SB(b, h) + boff + n * 2048 + k * 1024); } while (0)
#define PG8_MMA(ai, bj, At, Bt) do { __builtin_amdgcn_s_setprio(1); _Pragma("unroll") for (int m = 0; m < 4; ++m) _Pragma("unroll") for (int n = 0; n < 2; ++n) _Pragma("unroll") for (int k = 0; k < 2; ++k) \
        acc[ai][bj][m][n] = __builtin_amdgcn_mfma_f32_16x16x32_bf16(Bt[n][k], At[m][k], acc[ai][bj][m][n], 0, 0, 0); __builtin_amdgcn_s_setprio(0); } while (0)
#define PG8_WAIT_V(n) asm volatile("s_waitcnt vmcnt(" #n ")" ::: "memory")
#define PG8_WAIT_L(n) asm volatile("s_waitcnt lgkmcnt(" #n ")" ::: "memory")
#define PG8_BAR __builtin_amdgcn_s_barrier()
#define PG8_SCHED __builtin_amdgcn_sched_barrier(0)
    Unit cur, nxt; int ui = 0;
    if (!S.next(0, cur)) return;
    f32x4 acc[2][2][4][2];
#pragma unroll
    for (int a = 0; a < 2; ++a)
#pragma unroll
        for (int b = 0; b < 2; ++b)
#pragma unroll
            for (int m = 0; m < 4; ++m)
#pragma unroll
                for (int n = 0; n < 2; ++n) acc[a][b][m][n] = (f32x4){0.f, 0.f, 0.f, 0.f};
    bf16x8 At[4][2], B0[2][2], B1[2][2];
    const char* cA = (const char*)g.A + (size_t)cur.pm * tstepA; const char* cB = (const char*)g.Bt + (size_t)cur.pn * tstep;
    S.a_ready(cur);
    if constexpr (SP2) {
        PG8_STAGE(PG8_SB(0, 0), cB, voffB); PG8_STAGE(PG8_SB(0, 1), cB + hstep, voffB); PG8_STAGE(PG8_SA(0, 0), cA, voffA); PG8_STAGE(PG8_SA(0, 1), cA + hstepA, voffA);
        if (wr == 1) PG8_BAR;
        PG8_WAIT_V(2); PG8_BAR;
        PG8_STAGE(PG8_SB(1, 0), cB + kstep, voffB); PG8_STAGE(PG8_SA(1, 0), cA + kstep, voffA); PG8_STAGE(PG8_SB(1, 1), cB + hstep + kstep, voffB);
        PG8_WAIT_V(6); PG8_BAR;
    } else {
        PG8_STAGE(PG8_SB(0, 0), cB, voffB); PG8_STAGE(PG8_SA(0, 0), cA, voffA); PG8_STAGE(PG8_SB(0, 1), cB + hstep, voffB); PG8_STAGE(PG8_SA(0, 1), cA + hstepA, voffA);
        if (wr == 1) PG8_BAR;
        PG8_WAIT_V(4); PG8_BAR;
        PG8_STAGE(PG8_SB(1, 0), cB + kstep, voffB); PG8_STAGE(PG8_SA(1, 0), cA + kstep, voffA); PG8_STAGE(PG8_SB(1, 1), cB + hstep + kstep, voffB);
        PG8_WAIT_V(6); PG8_BAR;
    }
    for (;;) {
        const bool has_next = S.next(ui + 1, nxt);
        const char* nA = has_next ? (const char*)g.A + (size_t)nxt.pm * tstepA : cA; const char* nB = has_next ? (const char*)g.Bt + (size_t)nxt.pn * tstep : cB;
        for (int t = 0; t < nt; t += 2) {
            if constexpr (Epi::MID) { if (t == nt / 2) E.mid(acc, cur, wr, wc, fr, fq); }
            const bool last = (t == nt - 2);
            const char* a1 = cA + (size_t)(t + 1) * kstep;
            const char* a2 = last ? nA : cA + (size_t)(t + 2) * kstep; const char* b2 = last ? nB : cB + (size_t)(t + 2) * kstep;
            const char* a3 = a2 + kstep; const char* b3 = b2 + kstep;
            if (last && has_next) S.a_ready(nxt);
            if constexpr (SP2) {
            PG8_LDB(B0, 0, 0); PG8_LDB(B1, 0, 1); PG8_SCHED; PG8_LDA(At, 0, 0); PG8_STAGE(PG8_SA(1, 1), a1 + hstepA, voffA);
            PG8_WAIT_V(8); PG8_WAIT_L(0); PG8_BAR; PG8_MMA(0, 0, At, B0); PG8_MMA(0, 1, At, B1); PG8_BAR; PG8_SCHED;
            PG8_LDA(At, 0, 1); PG8_STAGE(PG8_SB(0, 0), b2, voffB); PG8_STAGE(PG8_SB(0, 1), b2 + hstep, voffB); PG8_STAGE(PG8_SA(0, 0), a2, voffA);
            PG8_WAIT_V(8); PG8_WAIT_L(0); PG8_BAR; PG8_MMA(1, 0, At, B0); PG8_MMA(1, 1, At, B1); PG8_BAR; PG8_SCHED;
            PG8_LDB(B0, 1, 0); PG8_LDB(B1, 1, 1); PG8_SCHED; PG8_LDA(At, 1, 0); PG8_STAGE(PG8_SA(0, 1), a2 + hstepA, voffA);
            PG8_WAIT_V(8); PG8_WAIT_L(0); PG8_BAR; PG8_MMA(0, 0, At, B0); PG8_MMA(0, 1, At, B1); PG8_BAR; PG8_SCHED;
            PG8_LDA(At, 1, 1); PG8_STAGE(PG8_SB(1, 0), b3, voffB); PG8_STAGE(PG8_SB(1, 1), b3 + hstep, voffB); PG8_STAGE(PG8_SA(1, 0), a3, voffA);
            PG8_WAIT_V(8); PG8_WAIT_L(0); PG8_BAR; PG8_MMA(1, 0, At, B0); PG8_MMA(1, 1, At, B1); PG8_BAR; PG8_SCHED;
            } else {
            PG8_LDB(B0, 0, 0); PG8_SCHED; PG8_LDA(At, 0, 0); PG8_STAGE(PG8_SA(1, 1), a1 + hstepA, voffA);
            PG8_WAIT_L(8); PG8_BAR; PG8_WAIT_L(0); PG8_MMA(0, 0, At, B0); PG8_BAR; PG8_SCHED;
            PG8_LDB(B1, 0, 1); PG8_STAGE(PG8_SB(0, 0), b2, voffB);
            PG8_BAR; PG8_WAIT_L(0); PG8_MMA(0, 1, At, B1); PG8_BAR;
            PG8_LDA(At, 0, 1); PG8_STAGE(PG8_SA(0, 0), a2, voffA);
            PG8_BAR; PG8_WAIT_L(0); PG8_MMA(1, 0, At, B0); PG8_BAR; PG8_SCHED;
            PG8_STAGE(PG8_SB(0, 1), b2 + hstep, voffB);
            PG8_WAIT_V(6); PG8_BAR; PG8_MMA(1, 1, At, B1); PG8_BAR;
            PG8_LDB(B0, 1, 0); PG8_SCHED; PG8_LDA(At, 1, 0); PG8_STAGE(PG8_SA(0, 1), a2 + hstepA, voffA);
            PG8_WAIT_L(8); PG8_BAR; PG8_WAIT_L(0); PG8_MMA(0, 0, At, B0); PG8_BAR; PG8_SCHED;
            PG8_LDB(B1, 1, 1); PG8_STAGE(PG8_SB(1, 0), b3, voffB);
            PG8_BAR; PG8_WAIT_L(0); PG8_MMA(0, 1, At, B1); PG8_BAR;
            PG8_LDA(At, 1, 1); PG8_STAGE(PG8_SA(1, 0), a3, voffA);
            PG8_BAR; PG8_WAIT_L(0); PG8_MMA(1, 0, At, B0); PG8_BAR; PG8_SCHED;
            PG8_STAGE(PG8_SB(1, 1), b3 + hstep, voffB);
            PG8_WAIT_V(6); PG8_BAR; PG8_MMA(1, 1, At, B1); PG8_BAR;
            }
        }
        if constexpr (ALIGN_EPI) { if (wr == 0) PG8_BAR; }
        if constexpr (!Epi::AFTER_DRAIN) { E(acc, cur, wr, wc, fr, fq); S.done(cur); }
        if (!has_next) break;
#pragma unroll
        for (int a = 0; a < 2; ++a)
#pragma unroll
            for (int b = 0; b < 2; ++b)
#pragma unroll
                for (int m = 0; m < 4; ++m)
#pragma unroll
                    for (int n = 0; n < 2; ++n) acc[a][b][m][n] = (f32x4){0.f, 0.f, 0.f, 0.f};
        cur = nxt; cA = nA; cB = nB; ++ui;
        if constexpr (ALIGN_EPI) { if (wr == 1) PG8_BAR; }
    }
    PG8_WAIT_V(0);
    if constexpr (!ALIGN_EPI) { if (wr == 0) PG8_BAR; }
    PG8_BAR;
    if constexpr (Epi::AFTER_DRAIN) { E.fused(acc, cur, wr, wc, fr, fq, lds, wid, lane); S.done(cur); }
#undef PG8_SA
#undef PG8_SB
#undef PG8_STAGE
#undef PG8_LDA
#undef PG8_LDB
#undef PG8_MMA
#undef PG8_WAIT_V
#undef PG8_WAIT_L
#undef PG8_BAR
#undef PG8_SCHED
}
}
#define LAS __attribute__((address_space(3)))
typedef unsigned short bf16;
typedef unsigned v4u __attribute__((ext_vector_type(4)));
typedef unsigned v2u __attribute__((ext_vector_type(2)));
typedef float f32x4 __attribute__((ext_vector_type(4)));
typedef float f32x2 __attribute__((ext_vector_type(2)));
typedef float f32x16 __attribute__((ext_vector_type(16)));
typedef short bf16x8 __attribute__((ext_vector_type(8)));
typedef short s16x4 __attribute__((ext_vector_type(4)));
using pg8::cvt_pk_bf16; using pg8::fsig;

constexpr int NWAVES = 8, NTHR = 512;
constexpr int SEQ = 4096, BATCH = 8, D = 1024, M = BATCH * SEQ, NIN = 7680;
constexpr float RMS_EPS = 1e-5f, LN_EPS = 1e-5f, LOG2E = 1.4426950408889634f;
constexpr size_t MiB = 1u << 20;
constexpr size_t WS_ROPE = 0;
constexpr size_t WS_SS = 1 * MiB;
constexpr size_t WS_W1 = 3 * MiB;
constexpr size_t WS_WCA = 18 * MiB;
constexpr size_t WS_WO = 22 * MiB;
constexpr size_t WS_U = 32 * MiB;
constexpr size_t WS_GLU = 160 * MiB;
constexpr size_t WS_CG = 224 * MiB;
constexpr size_t WS_K = 288 * MiB;
constexpr size_t WS_V = 304 * MiB;
constexpr size_t WS_AG = 320 * MiB;
constexpr size_t WS_GT = 384 * MiB;
constexpr size_t WS_BAR = 24 * MiB;
constexpr size_t WS_END = 512 * MiB;
#ifndef MK_CUTS
#define MK_CUTS {0, 6}
#endif
constexpr int CUTS[] = MK_CUTS;
constexpr int N_LAUNCHES = (int)(sizeof(CUTS) / sizeof(int)) - 1;
constexpr int LDS_BYTES = 147456;
constexpr int RING_BYTES = 131072;

__device__ __forceinline__ float wave_sum(float v) {
#pragma unroll
    for (int o = 1; o < 64; o <<= 1) v += __shfl_xor(v, o);
    return v;
}
#define LDS_WAIT() asm volatile("s_waitcnt lgkmcnt(0)" ::: "memory")

__device__ __forceinline__ void p0_transpose_item(const float* W, int N, bf16* WT, int ldo, int drow0, int kofs, LAS float* scr, int k0, int n0, int lane) {
#pragma unroll 8
    for (int i = 0; i < 32; ++i) { const int kk = 2 * i + (lane >> 5); scr[kk * 33 + (lane & 31)] = W[(size_t)(k0 + kk) * N + n0 + (lane & 31)]; }
    LDS_WAIT(); asm volatile("" ::: "memory");
    const int c = lane & 7;
#pragma unroll
    for (int j = 0; j < 4; ++j) { const int n = (lane >> 3) + 8 * j; const LAS float* s = scr + (8 * c) * 33 + n;
        v4u o; o.x = cvt_pk_bf16(s[0 * 33], s[1 * 33]); o.y = cvt_pk_bf16(s[2 * 33], s[3 * 33]); o.z = cvt_pk_bf16(s[4 * 33], s[5 * 33]); o.w = cvt_pk_bf16(s[6 * 33], s[7 * 33]);
        *(v4u*)(WT + (size_t)(drow0 + n) * ldo + kofs + k0 + 8 * c) = o; }
    LDS_WAIT(); asm volatile("" ::: "memory");
}
__device__ __forceinline__ int w1_dest_row(int n0) {
    if (n0 < 2048) { const int bj = n0 >> 10, rem = n0 & 1023; return 256 * (rem >> 7) + 128 * bj + (rem & 127); }
    if (n0 >= 3072 && n0 < 4352) { const int base = n0 < 4096 ? 3072 : 4096; const int lq = n0 - base, t = lq >> 8, l = lq & 255, head = l >> 6, bj = (l & 63) >> 5;
        return base + 256 * t + 128 * bj + 32 * head; }
    return n0;
}

struct Args { const float* in[12]; float* out; unsigned char* ws; int ph_lo, ph_hi; };

__device__ __forceinline__ void p0_prologue(const Args& a, LAS unsigned char* lds) {
    int tid = threadIdx.x; asm volatile("" : "+v"(tid)); const int lane = tid & 63, wave = __builtin_amdgcn_readfirstlane(tid >> 6);
    unsigned char* ws = a.ws;
    LAS float* scr = (LAS float*)(lds + wave * 16384);
    const int G = gridDim.x, gw = blockIdx.x * NWAVES + wave, NGW = G * NWAVES;
    constexpr int I_1 = 16 * (NIN / 32), I_S = 16 * 32;
    for (int it = gw; it < I_1 + 3 * I_S; it += NGW) {
        int r = it;
        if (r < I_1) { const int kb = r / (NIN / 32), nb = r % (NIN / 32); p0_transpose_item(a.in[2], NIN, (bf16*)(ws + WS_W1), 1024, w1_dest_row(32 * nb), 0, scr, 64 * kb, 32 * nb, lane); continue; } r -= I_1;
        const int kb = (r % I_S) / 32, nb = r % 32; const int which = r / I_S;
        if (which == 0) p0_transpose_item(a.in[7], 1024, (bf16*)(ws + WS_WCA), 2048, 32 * nb, 0, scr, 64 * kb, 32 * nb, lane);
        else if (which == 1) p0_transpose_item(a.in[9], 1024, (bf16*)(ws + WS_WCA), 2048, 32 * nb, 1024, scr, 64 * kb, 32 * nb, lane);
        else p0_transpose_item(a.in[10], 1024, (bf16*)(ws + WS_WO), 1024, 32 * nb, 0, scr, 64 * kb, 32 * nb, lane);
    }
    const float* x = a.in[0]; const float* ng = a.in[1]; bf16* U = (bf16*)(ws + WS_U);
    f32x4 gv[4];
#pragma unroll
    for (int j = 0; j < 4; ++j) gv[j] = *((const f32x4*)ng + lane + 64 * j);
    for (int m = gw; m < M; m += NGW) {
        const f32x4* xr = (const f32x4*)(x + (size_t)m * D) + lane; f32x4 v[4]; float s = 0.f;
#pragma unroll
        for (int j = 0; j < 4; ++j) { v[j] = xr[64 * j]; s += (v[j].x * v[j].x + v[j].y * v[j].y) + (v[j].z * v[j].z + v[j].w * v[j].w); }
        const float r = 1.0f / sqrtf(wave_sum(s) * (1.f / D) + RMS_EPS);
        v2u* o8 = (v2u*)(U + (size_t)m * 2048) + lane;
#pragma unroll
        for (int j = 0; j < 4; ++j) { v2u o; o.x = cvt_pk_bf16(v[j].x * r * gv[j].x, v[j].y * r * gv[j].y); o.y = cvt_pk_bf16(v[j].z * r * gv[j].z, v[j].w * r * gv[j].w); o8[64 * j] = o; }
    }
    float* rope = (float*)(ws + WS_ROPE);
    for (int e = blockIdx.x * NTHR + tid; e < SEQ * 32; e += G * NTHR) {
        const int pos = e >> 5, i = e & 31;
        const float inv = exp2f(-(float)(2 * i) * (13.287712379549449f / 64.0f));
        const float angf = (float)pos * inv;
        const double ang = (double)angf; const double kq = __builtin_rint(ang * 0.6366197723675814);
        double rr = __builtin_fma(-kq, 1.5707963267948966, ang); rr = __builtin_fma(-kq, 6.123233995736766e-17, rr);
        const double r2 = rr * rr;
        const double sn = rr * (1.0 + r2 * (-1.0 / 6 + r2 * (1.0 / 120 + r2 * (-1.0 / 5040 + r2 * (1.0 / 362880 + r2 * (-1.0 / 39916800))))));
        const double cs = 1.0 + r2 * (-0.5 + r2 * (1.0 / 24 + r2 * (-1.0 / 720 + r2 * (1.0 / 40320 + r2 * (-1.0 / 3628800 + r2 * (1.0 / 479001600))))));
        const int q = (int)kq & 3; double c, s;
        if (q == 0) { c = cs; s = sn; } else if (q == 1) { c = -sn; s = cs; } else if (q == 2) { c = -cs; s = -sn; } else { c = sn; s = -cs; }
        *(f32x2*)(rope + (size_t)e * 2) = (f32x2){(float)c, (float)s};
    }
}

__device__ __forceinline__ void conv_unit(const Args& a, LAS unsigned char* lds, int cu) {
    int tid = threadIdx.x; asm volatile("" : "+v"(tid)); const int lane = tid & 63, wave = __builtin_amdgcn_readfirstlane(tid >> 6);
    unsigned char* ws = a.ws;
    const bf16* GLU = (const bf16*)(ws + WS_GLU); const bf16* CG = (const bf16*)(ws + WS_CG); bf16* U = (bf16*)(ws + WS_U);
    const float* wdw = a.in[3]; const float* bdw = a.in[4]; const float* lg = a.in[5]; const float* lb = a.in[6];
    const int t0 = 32 * cu, sp0 = t0 & (SEQ - 1), c = 2 * tid;
    LAS float* cv = (LAS float*)lds;
    {
        f32x2 in[62];
#pragma unroll
        for (int i = 0; i < 62; ++i) { unsigned v = 0u; if (sp0 - 30 + i >= 0) v = *(const unsigned*)(GLU + (size_t)(t0 - 30 + i) * 1024 + c);
            in[i] = (f32x2){__uint_as_float(v << 16), __uint_as_float(v & 0xffff0000u)}; }
        f32x2 w[31];
#pragma unroll
        for (int j = 0; j < 31; ++j) w[j] = *(const f32x2*)(wdw + j * 1024 + c);
        const f32x2 bias = *(const f32x2*)(bdw + c);
#pragma unroll
        for (int tt = 0; tt < 32; ++tt) { f32x2 acc = bias;
#pragma unroll
            for (int j = 0; j < 31; ++j) acc = w[j] * in[tt + j] + acc;
            *(LAS f32x2*)(cv + tt * 1024 + c) = acc; }
    }
    __syncthreads();
#pragma unroll 1
    for (int rr = 0; rr < 4; ++rr) { const int tt = wave + 8 * rr; const size_t row = (size_t)t0 + tt;
        f32x4 v[4]; float s = 0.f;
#pragma unroll
        for (int j = 0; j < 4; ++j) { v[j] = *(const LAS f32x4*)(cv + tt * 1024 + 4 * lane + 256 * j); s += (v[j].x + v[j].y) + (v[j].z + v[j].w); }
        const float mean = wave_sum(s) * (1.f / 1024); float s2 = 0.f;
#pragma unroll
        for (int j = 0; j < 4; ++j) { v[j] = v[j] - mean; s2 += (v[j].x * v[j].x + v[j].y * v[j].y) + (v[j].z * v[j].z + v[j].w * v[j].w); }
        const float rstd = 1.0f / sqrtf(wave_sum(s2) * (1.f / 1024) + LN_EPS);
#pragma unroll
        for (int j = 0; j < 4; ++j) { const int col = 4 * lane + 256 * j;
            const f32x4 g4 = *(const f32x4*)(lg + col), b4 = *(const f32x4*)(lb + col); const v2u cg = *(const v2u*)(CG + row * 1024 + col);
            f32x4 y = v[j] * rstd * g4 + b4;
            y.x *= fsig(y.x) * __uint_as_float(cg.x << 16); y.y *= fsig(y.y) * __uint_as_float(cg.x & 0xffff0000u);
            y.z *= fsig(y.z) * __uint_as_float(cg.y << 16); y.w *= fsig(y.w) * __uint_as_float(cg.y & 0xffff0000u);
            v2u o; o.x = cvt_pk_bf16(y.x, y.y); o.y = cvt_pk_bf16(y.z, y.w); *(v2u*)(U + row * 2048 + col) = o; }
    }
    __syncthreads();
}

constexpr int KS_STRIDE = 144, VS_STRIDE = 192, VS_OFF = 256 * KS_STRIDE;
__device__ __forceinline__ int crow(int r, int hi) { return (r & 3) + 8 * (r >> 2) + 4 * hi; }
__device__ __forceinline__ void attn_unit(const Args& a, LAS unsigned char* lds, int au) {
    int tid = threadIdx.x; asm volatile("" : "+v"(tid)); const int lane = tid & 63, wave = __builtin_amdgcn_readfirstlane(tid >> 6);
    unsigned char* ws = a.ws;
    bf16* U = (bf16*)(ws + WS_U); const bf16* Kb = (const bf16*)(ws + WS_K); const bf16* Vb = (const bf16*)(ws + WS_V); const bf16* AG = (const bf16*)(ws + WS_AG);
    const int b = au >> 7, nb = (au >> 2) & 31, g = au & 3;
    const long R0 = (long)b * SEQ + 128 * nb;
#pragma unroll
    for (int i = 0; i < 4; ++i) { const int ch = tid + NTHR * i, key = ch >> 3, c8 = ch & 7; v4u kv = (v4u){0u, 0u, 0u, 0u}, vv = kv;
        if (nb > 0 || key >= 128) { const size_t off = (size_t)(R0 - 128 + key) * 256 + 64 * g + 8 * c8; kv = *(const v4u*)(Kb + off); vv = *(const v4u*)(Vb + off); }
        *(LAS v4u*)(lds + key * KS_STRIDE + c8 * 16) = kv; *(LAS v4u*)(lds + VS_OFF + key * VS_STRIDE + c8 * 16) = vv; }
    __syncthreads();
    const int hq = wave >> 1, head = 4 * g + hq, ql = lane & 31, hi = lane >> 5;
    const float sk2 = a.in[8][head] * LOG2E;
#pragma unroll 1
    for (int st = 0; st < 2; ++st) {
        const int q0 = 64 * (wave & 1) + 32 * st;
        const size_t qrow = (size_t)(R0 + q0 + ql);
        bf16* qp = U + qrow * 2048 + 1024 + 64 * head;
        bf16x8 qf[4];
#pragma unroll
        for (int kk = 0; kk < 4; ++kk) qf[kk] = *(const bf16x8*)(qp + 16 * kk + 8 * hi);
        f32x16 s[5];
#pragma unroll
        for (int j = 0; j < 5; ++j) {
            s[j] = (f32x16){};
#pragma unroll
            for (int kk = 0; kk < 4; ++kk) { const bf16x8 kf = *(const LAS bf16x8*)(lds + (q0 + 32 * j + ql) * KS_STRIDE + (16 * kk + 8 * hi) * 2);
                s[j] = __builtin_amdgcn_mfma_f32_32x32x16_bf16(kf, qf[kk], s[j], 0, 0, 0); }
        }
        float mx = sk2;
#pragma unroll
        for (int j = 0; j < 5; ++j)
#pragma unroll
            for (int r = 0; r < 16; ++r) { const int cr = crow(r, hi); bool ok = true;
                if (j == 0) ok = cr > ql; if (j == 4) ok = cr <= ql;
                if (nb == 0) ok = ok && (q0 + 32 * j + cr >= 128);
                const float v = ok ? s[j][r] : -1e30f; s[j][r] = v; mx = fmaxf(mx, v); }
        mx = fmaxf(mx, __shfl_xor(mx, 32));
        float l = 0.f;
#pragma unroll
        for (int j = 0; j < 5; ++j)
#pragma unroll
            for (int r = 0; r < 16; ++r) { const float p = __builtin_amdgcn_exp2f(s[j][r] - mx); s[j][r] = p; l += p; }
        l += __shfl_xor(l, 32);
        l += __builtin_amdgcn_exp2f(sk2 - mx);
        const float rl = 1.0f / l;
        f32x16 o[2]; o[0] = (f32x16){}; o[1] = (f32x16){};
        const int g4 = lane >> 4, li = lane & 15;
        const int vbase = VS_OFF + (q0 + 4 * (g4 >> 1) + (li >> 2)) * VS_STRIDE + (16 * (g4 & 1) + 4 * (li & 3)) * 2;
#pragma unroll
        for (int j = 0; j < 5; ++j)
#pragma unroll
            for (int s2 = 0; s2 < 2; ++s2) {
                v4u pw; pw.x = cvt_pk_bf16(s[j][8 * s2 + 0], s[j][8 * s2 + 1]); pw.y = cvt_pk_bf16(s[j][8 * s2 + 2], s[j][8 * s2 + 3]);
                pw.z = cvt_pk_bf16(s[j][8 * s2 + 4], s[j][8 * s2 + 5]); pw.w = cvt_pk_bf16(s[j][8 * s2 + 6], s[j][8 * s2 + 7]);
                const bf16x8 pf = __builtin_bit_cast(bf16x8, pw);
#pragma unroll
                for (int dt = 0; dt < 2; ++dt) {
                    const int ad = vbase + (32 * j + 16 * s2) * VS_STRIDE + 64 * dt;
                    const s16x4 lo = __builtin_bit_cast(s16x4, __builtin_amdgcn_ds_read_tr16_b64_v4i16((LAS s16x4*)(lds + ad)));
                    const s16x4 h4 = __builtin_bit_cast(s16x4, __builtin_amdgcn_ds_read_tr16_b64_v4i16((LAS s16x4*)(lds + ad + 8 * VS_STRIDE)));
                    const bf16x8 vf = (bf16x8){lo[0], lo[1], lo[2], lo[3], h4[0], h4[1], h4[2], h4[3]};
                    o[dt] = __builtin_amdgcn_mfma_f32_32x32x16_bf16(vf, pf, o[dt], 0, 0, 0);
                }
            }
        const bf16* agp = AG + qrow * 1024 + 64 * head;
#pragma unroll
        for (int dt = 0; dt < 2; ++dt)
#pragma unroll
            for (int r4 = 0; r4 < 4; ++r4) { const int d = 32 * dt + 8 * r4 + 4 * hi; const v2u gq = *(const v2u*)(agp + d);
                v2u w; w.x = cvt_pk_bf16(o[dt][4 * r4 + 0] * rl * __uint_as_float(gq.x << 16), o[dt][4 * r4 + 1] * rl * __uint_as_float(gq.x & 0xffff0000u));
                w.y = cvt_pk_bf16(o[dt][4 * r4 + 2] * rl * __uint_as_float(gq.y << 16), o[dt][4 * r4 + 3] * rl * __uint_as_float(gq.y & 0xffff0000u));
                *(v2u*)(qp + d) = w; }
    }
    __syncthreads();
}

#define GAS __attribute__((address_space(1)))
#define XB_TMO      128
#define XB_XCNT(j)  (256  + 64 * (j))
#define XB_XSUB(j)  (1280 + 64 * (j))
#define XB_XGEN(j)  (2304 + 64 * (j))
#define XB_TOP      3328
#define XB_TOPGEN   3392
#define XCD_BAR_WORDS 3456
#define XB_SPIN_CAP (1u << 18)

__device__ __forceinline__ unsigned xb_ld(unsigned* p)              { return __hip_atomic_load(p, __ATOMIC_RELAXED, __HIP_MEMORY_SCOPE_AGENT); }
__device__ __forceinline__ unsigned xb_add(unsigned* p, unsigned v) { return __hip_atomic_fetch_add(p, v, __ATOMIC_RELAXED, __HIP_MEMORY_SCOPE_AGENT); }
__device__ __forceinline__ unsigned xb_xcc_id() { return (unsigned)__builtin_amdgcn_s_getreg((3 << 11) | 20) & 0xFu; }
#define XB_SPIN(cond, bar) do { unsigned _sp = 0; while (cond) { __builtin_amdgcn_s_sleep(1); \
    if ((++_sp & 255u) == 0u) { if (xb_ld(&(bar)[XB_TMO])) break; if (_sp > XB_SPIN_CAP) { atomicAdd(&(bar)[XB_TMO], 1u); break; } } } } while (0)

struct XcdBarrier {
    unsigned* bar; unsigned x;
    volatile LAS unsigned* st;
};

__device__ __forceinline__ XcdBarrier xcd_barrier_post(unsigned* bar, volatile LAS unsigned* st) {
    XcdBarrier b; b.bar = bar; b.x = xb_xcc_id(); b.st = st;
    if (threadIdx.x == 0) (void)xb_add(&bar[XB_XCNT(b.x)], 1u);
    return b;
}
__device__ __forceinline__ void xcd_barrier_complete(unsigned* bar, unsigned x, unsigned& nloc, unsigned& nx) {
    const unsigned G = gridDim.x * gridDim.y * gridDim.z;
    unsigned sum, cnt, mine, sp = 0u;
    for (;;) {
        sum = 0u; cnt = 0u; mine = 0u;
#pragma unroll
        for (unsigned j = 0; j < 16; ++j) { const unsigned c = xb_ld(&bar[XB_XCNT(j)]); sum += c; cnt += (c > 0u) ? 1u : 0u; mine = (j == x) ? c : mine; }
        if (sum == G) break;
        __builtin_amdgcn_s_sleep(1);
        if ((++sp & 255u) == 0u) { if (xb_ld(&bar[XB_TMO])) break; if (sp > XB_SPIN_CAP) { atomicAdd(&bar[XB_TMO], 1u); break; } }
    }
    nloc = mine > 0u ? mine : 1u; nx = cnt > 0u ? cnt : 1u;
}

__device__ __forceinline__ void xcd_barrier(const XcdBarrier& b) {
    asm volatile("s_waitcnt vmcnt(0)" ::: "memory");
    __syncthreads();
    if (threadIdx.x == 0) {
        unsigned* bar = b.bar;
        __builtin_amdgcn_s_waitcnt(0);
        unsigned nloc = b.st[0], nx = b.st[1];
        if (nloc == 0u) { xcd_barrier_complete(bar, b.x, nloc, nx); b.st[0] = nloc; b.st[1] = nx; }
        const unsigned old = xb_add(&bar[XB_XSUB(b.x)], 1u);
        const unsigned gen = old / nloc;
        if (old + 1u == (gen + 1u) * nloc) {
            __builtin_amdgcn_fence(__ATOMIC_RELEASE, "agent");
            asm volatile("s_waitcnt vmcnt(0)" ::: "memory");
            const unsigned og = xb_add(&bar[XB_TOP], 1u);
            const unsigned tg = og / nx;
            if (og + 1u == (tg + 1u) * nx) xb_add(&bar[XB_TOPGEN], 1u);
            else XB_SPIN(xb_ld(&bar[XB_TOPGEN]) == tg, bar);
            __builtin_amdgcn_fence(__ATOMIC_ACQUIRE, "agent");
            xb_add(&bar[XB_XGEN(b.x)], 1u);
            asm volatile("s_waitcnt vmcnt(0)" ::: "memory");
        } else {
            XB_SPIN(xb_ld(&bar[XB_XGEN(b.x)]) == gen, bar);
            __builtin_amdgcn_fence(__ATOMIC_ACQUIRE, "agent");
            asm volatile("s_waitcnt vmcnt(0)" ::: "memory");
        }
    }
    __syncthreads();
}

#define GRID_SYNC() xcd_barrier(xbar)
__global__ void __launch_bounds__(NTHR, 2) mega_fwd(Args args) {
    extern __shared__ __attribute__((aligned(16))) unsigned char lds_raw[];
    cg::grid_group grid = cg::this_grid();
    LAS unsigned char* lds = (LAS unsigned char*)lds_raw;
    unsigned char* ws = args.ws;
    const int G = gridDim.x;
    if (threadIdx.x < 2) ((volatile LAS unsigned*)(lds + RING_BYTES))[threadIdx.x] = 0u;
    __syncthreads();
    XcdBarrier xbar = xcd_barrier_post((unsigned*)(ws + WS_BAR), (volatile LAS unsigned*)(lds + RING_BYTES));
    grid.sync();
    const int lo = args.ph_lo, hi = args.ph_hi;
#if defined(MK_DIAG)
    volatile LAS unsigned long long* tsl = (volatile LAS unsigned long long*)(lds + RING_BYTES + 256);
#define STAMP(k) do { if (blockIdx.x == 0 && threadIdx.x == 0) tsl[k] = __builtin_amdgcn_s_memrealtime(); } while (0)
#else
#define STAMP(k) do {} while (0)
#endif
    STAMP(0);
#define IN(k) (lo <= (k) && (k) < hi)
#if defined(MK_REPEAT)
#define REPS(k) ((k) == MK_REPEAT ? 2 : 1)
#else
#define REPS(k) 1
#endif
#define SEAM(k) do { if (IN(k) && IN((k) + 1)) GRID_SYNC(); STAMP((k) + 1); } while (0)
    for (int rep = 0; rep < REPS(0); ++rep) { if (rep) GRID_SYNC(); if (IN(0)) p0_prologue(args, lds); }
    SEAM(0);
    for (int rep = 0; rep < REPS(1); ++rep) { if (rep) GRID_SYNC();
    if (IN(1)) {
        pg8::Gemm g{(const pg8::bf16_t*)(ws + WS_U), (const pg8::bf16_t*)(ws + WS_W1), M, NIN, D, 2048};
        pg8::StaticOrder S; S.init(M, NIN, G, (int)blockIdx.x);
        pg8::EpiProj E{(bf16*)(ws + WS_GLU), (bf16*)(ws + WS_CG), (bf16*)(ws + WS_U) + 1024, (bf16*)(ws + WS_K), (bf16*)(ws + WS_V), (bf16*)(ws + WS_AG), (bf16*)(ws + WS_GT), (const float*)(ws + WS_ROPE)};
        pg8::gemm_phase<pg8::EpiProj, pg8::StaticOrder, true, true>(lds, g, S, E);
    } }
    SEAM(1);
    if (IN(2)) {
        for (int u = blockIdx.x; u < 1024; u += G) attn_unit(args, lds, u);
        for (int rep = 0; rep < REPS(2); ++rep) for (int u = blockIdx.x; u < 1024; u += G) conv_unit(args, lds, u);
    }
    SEAM(2);
    for (int rep = 0; rep < REPS(3); ++rep) { if (rep) GRID_SYNC();
    if (IN(3)) {
        pg8::Gemm g{(const pg8::bf16_t*)(ws + WS_U), (const pg8::bf16_t*)(ws + WS_WCA), M, D, 2048, 2048};
        pg8::StaticOrder S; S.init(M, D, G, (int)blockIdx.x);
        pg8::EpiMerge E{(const bf16*)(ws + WS_GT), (bf16*)(ws + WS_GLU)};
        pg8::gemm_phase<pg8::EpiMerge, pg8::StaticOrder, true, true>(lds, g, S, E);
    } }
    SEAM(3);
    for (int rep = 0; rep < REPS(4); ++rep) { if (rep) GRID_SYNC();
    if (IN(4)) {
        pg8::Gemm g{(const pg8::bf16_t*)(ws + WS_GLU), (const pg8::bf16_t*)(ws + WS_WO), M, D, D, 1024};
        pg8::StaticOrder S; S.init(M, D, G, (int)blockIdx.x);
        pg8::EpiOut E{args.in[0], args.out, (float*)(ws + WS_SS)};
        pg8::gemm_phase<pg8::EpiOut, pg8::StaticOrder, true, true>(lds, g, S, E);
    } }
    SEAM(4);
    if (IN(5)) {
        int tid = threadIdx.x; asm volatile("" : "+v"(tid)); const int lane = tid & 63, wave = __builtin_amdgcn_readfirstlane(tid >> 6);
        const float* SS = (const float*)(ws + WS_SS); const float* fg = args.in[11]; float* out = args.out;
        f32x4 gv[4];
#pragma unroll
        for (int j = 0; j < 4; ++j) gv[j] = *((const f32x4*)fg + lane + 64 * j);
        for (int m = blockIdx.x * NWAVES + wave; m < M; m += G * NWAVES) {
            float s = SS[(size_t)m * 16 + (lane & 15)];
            s += __shfl_xor(s, 1); s += __shfl_xor(s, 2); s += __shfl_xor(s, 4); s += __shfl_xor(s, 8);
            const float r = 1.0f / sqrtf(s * (1.f / D) + RMS_EPS);
            f32x4* orow = (f32x4*)(out + (size_t)m * D) + lane;
#pragma unroll
            for (int j = 0; j < 4; ++j) { f32x4 v = orow[64 * j]; orow[64 * j] = v * r * gv[j]; }
        }
    }
#if defined(MK_DIAG)
    {
        GRID_SYNC(); STAMP(6);
        if (blockIdx.x == 0) { const float dA = (float)(tsl[2 * MK_DIAG + 1] - tsl[2 * MK_DIAG]) * 0.01f, dB = (float)(tsl[2 * MK_DIAG + 2] - tsl[2 * MK_DIAG + 1]) * 0.01f;
            if (threadIdx.x == 0) args.out[0] = 100.f * dA;
            for (int e = threadIdx.x; e < (1 << 20); e += NTHR) args.out[(1 << 20) + e] += dB; }
    }
#endif
#if defined(MK_DUMP)
    if (lo == 7) {
        int tid = threadIdx.x; const int lane = tid & 63, wave = tid >> 6; float* out = args.out;
        const bf16 *GLUp = (const bf16*)(ws + WS_GLU), *CGp = (const bf16*)(ws + WS_CG), *AGp = (const bf16*)(ws + WS_AG), *Up = (const bf16*)(ws + WS_U), *GTp = (const bf16*)(ws + WS_GT), *Kp = (const bf16*)(ws + WS_K), *Vp = (const bf16*)(ws + WS_V);
        for (int m = blockIdx.x * NWAVES + wave; m < M; m += G * NWAVES)
            for (int c = lane; c < 1024; c += 64) { float v = 0.f;
#define BF(p_) __uint_as_float((unsigned)(p_) << 16)
                if (MK_DUMP == 1) v = BF(Up[(size_t)m * 2048 + c]) + ((const float*)(ws + WS_ROPE))[(size_t)(m & 4095) * 64 + (c & 63)] + BF(((const bf16*)(ws + WS_W1))[(size_t)(m % 7680) * 1024 + c]) + BF(((const bf16*)(ws + WS_WCA))[(size_t)(m & 1023) * 2048 + c]) + BF(((const bf16*)(ws + WS_WCA))[(size_t)(m & 1023) * 2048 + 1024 + c]) + BF(((const bf16*)(ws + WS_WO))[(size_t)(m & 1023) * 1024 + c]);
                if (MK_DUMP == 2) v = BF(GLUp[(size_t)m * 1024 + c]) + BF(CGp[(size_t)m * 1024 + c]) + BF(AGp[(size_t)m * 1024 + c]) + BF(Up[(size_t)m * 2048 + 1024 + c]) + BF(GTp[(size_t)m * 2048 + c]) + BF(GTp[(size_t)m * 2048 + 1024 + c]) + BF(Kp[(size_t)m * 256 + (c & 255)]) + BF(Vp[(size_t)m * 256 + (c & 255)]);
                if (MK_DUMP == 21) v = BF(GLUp[(size_t)m * 1024 + c]) + BF(CGp[(size_t)m * 1024 + c]) + BF(AGp[(size_t)m * 1024 + c]) + BF(GTp[(size_t)m * 2048 + c]) + BF(GTp[(size_t)m * 2048 + 1024 + c]);
                if (MK_DUMP == 22) v = BF(Up[(size_t)m * 2048 + 1024 + c]) + BF(Kp[(size_t)m * 256 + (c & 255)]) + BF(Vp[(size_t)m * 256 + (c & 255)]);
                if (MK_DUMP == 3) v = BF(Up[(size_t)m * 2048 + c]) + BF(Up[(size_t)m * 2048 + 1024 + c]);
                if (MK_DUMP == 4) v = BF(GLUp[(size_t)m * 1024 + c]);
                if (MK_DUMP == 5) v = out[(size_t)m * 1024 + c] + ((const float*)(ws + WS_SS))[(size_t)m * 16 + (c & 15)];
                out[(size_t)m * 1024 + c] = v; }
    }
#endif
#undef IN
#undef SEAM
}

extern "C" void kernel_launch(void* const* d_in, const int* in_sizes, int n_in, void* d_out, int out_size, void* d_ws, size_t ws_size, hipStream_t stream) {
    static int grid = 0;
    if (grid == 0) {
        if (n_in != 12 || in_sizes[0] != M * D || out_size != M * D || ws_size < WS_END) { fprintf(stderr, "kernel_launch: unexpected shapes (n_in %d, in0 %d, out %d, ws %zu)\n", n_in, n_in > 0 ? in_sizes[0] : -1, out_size, ws_size); grid = -1; return; }
        int dev = 0, cus = 0, per_cu = 0;
        if (hipGetDevice(&dev) != hipSuccess || hipDeviceGetAttribute(&cus, hipDeviceAttributeMultiprocessorCount, dev) != hipSuccess) { grid = -1; return; }
        if (hipFuncSetAttribute((const void*)mega_fwd, hipFuncAttributeMaxDynamicSharedMemorySize, LDS_BYTES) != hipSuccess) { fprintf(stderr, "kernel_launch: hipFuncSetAttribute failed\n"); grid = -1; return; }
        if (hipOccupancyMaxActiveBlocksPerMultiprocessor(&per_cu, (const void*)mega_fwd, NTHR, LDS_BYTES) != hipSuccess || per_cu < 1) { fprintf(stderr, "kernel_launch: occupancy query failed (%d)\n", per_cu); grid = -1; return; }
        grid = cus * per_cu;
        fprintf(stderr, "kernel_launch: grid %d (%d CUs x %d)\n", grid, cus, per_cu);
    }
    if (grid < 0) return;
    if (hipMemsetAsync((char*)d_ws + WS_BAR, 0, 16384, stream) != hipSuccess) { fprintf(stderr, "kernel_launch: memset of the barrier words failed\n"); return; }
    Args a{};
    for (int i = 0; i < 12; ++i) a.in[i] = (const float*)d_in[i];
    a.out = (float*)d_out; a.ws = (unsigned char*)d_ws;
    for (int li = 0; li < N_LAUNCHES; ++li) {
        a.ph_lo = CUTS[li]; a.ph_hi = CUTS[li + 1];
        void* kargs[] = {&a};
        hipError_t e = hipLaunchCooperativeKernel((const void*)mega_fwd, dim3(grid), dim3(NTHR), kargs, LDS_BYTES, stream);
        if (e != hipSuccess) { fprintf(stderr, "kernel_launch: cooperative launch failed: %s (grid %d)\n", hipGetErrorString(e), grid); break; }
    }
#if defined(MK_DUMP)
    { a.ph_lo = 7; a.ph_hi = 8; void* kargs[] = {&a}; (void)hipLaunchCooperativeKernel((const void*)mega_fwd, dim3(grid), dim3(NTHR), kargs, LDS_BYTES, stream); }
#endif
}
```
